# Optimizing an MI355X kernel written in HIP

```python
import math
import jax, jax.numpy as jnp
from jax import lax
import numpy as np


D_MODEL = 1024
BATCH = 2
SEQ = 8192
DEPTH = 4

D_MIX = D_MODEL
SSD_WIDTH = D_MIX // 2
SSD_HEADDIM = 64
SSD_HEADS = SSD_WIDTH // SSD_HEADDIM
SSD_GROUPS = 2
SSD_HEADS_PER_GROUP = SSD_HEADS // SSD_GROUPS
SSD_STATE = 128
SSD_XBC = SSD_WIDTH + 2 * SSD_GROUPS * SSD_STATE
CONV_WIDTH = 4
CHUNK = 128
ATTN_WIDTH = D_MIX - SSD_WIDTH
DIFF_HEAD_DIM = 64
DIFF_HEADS = ATTN_WIDTH // (2 * DIFF_HEAD_DIM)
DIFF_V_DIM = 2 * DIFF_HEAD_DIM
ATTN_QK = DIFF_HEADS * 2 * DIFF_HEAD_DIM
ATTN_V = DIFF_HEADS * DIFF_V_DIM
Q_BLOCK = 128
ROPE_THETA = 10000.0
D_FF = -(-(8 * D_MODEL) // (3 * 256)) * 256
IN_SPLITS = (SSD_WIDTH, SSD_XBC, SSD_HEADS, ATTN_QK, ATTN_QK, ATTN_V)
D_IN_PROJ = SSD_WIDTH + SSD_XBC + SSD_HEADS + 2 * ATTN_QK + ATTN_V
ALPHA = (2 * DEPTH) ** 0.25
BETA = (8 * DEPTH) ** -0.25
N_MOD = 6
EPS = 1e-5

kernel_name = 'hymba_ssd_diffattn_deepnorm_adaln'


def layer_norm(x, g, b):
    xf = x.astype(jnp.float32)
    mu = jnp.mean(xf, -1, keepdims=True)
    var = jnp.mean(jnp.square(xf - mu), -1, keepdims=True)
    return ((xf - mu) * lax.rsqrt(var + EPS) * g + b).astype(x.dtype)


def rms_norm(x, g):
    xf = x.astype(jnp.float32)
    return (xf * lax.rsqrt(jnp.mean(xf * xf, -1, keepdims=True) + EPS) * g).astype(x.dtype)


def rope_tables(seq, dim):
    inv = 1.0 / (ROPE_THETA ** (jnp.arange(0, dim, 2, dtype=jnp.float32) / dim))
    ang = jnp.arange(seq, dtype=jnp.float32)[:, None] * inv[None, :]
    ang = jnp.concatenate([ang, ang], -1)
    return jnp.cos(ang), jnp.sin(ang)


def apply_rope(x, cos, sin):
    half = x.shape[-1] // 2
    rot = jnp.concatenate([-x[..., half:], x[..., :half]], -1)
    shape = (1, cos.shape[0]) + (1,) * (x.ndim - 3) + (cos.shape[1],)
    return x * cos.reshape(shape) + rot * sin.reshape(shape)


def causal_depthwise_conv(u, w, b):
    k = w.shape[0]
    out = lax.conv_general_dilated(
        u, w[:, None, :].astype(u.dtype), window_strides=(1,), padding=((k - 1, 0),),
        dimension_numbers=('NWC', 'WIO', 'NWC'), feature_group_count=u.shape[-1])
    return out + b


def segsum_exp(a):
    cs = jnp.cumsum(a, -1)
    n = a.shape[-1]
    diff = cs[..., :, None] - cs[..., None, :]
    mask = jnp.tril(jnp.ones((n, n), dtype=bool))
    return jnp.exp(jnp.where(mask, diff, -jnp.inf))


def ssd_chunked(xs, a, bm, cm):
    f32 = jnp.float32
    xs, a, bm, cm = xs.astype(f32), a.astype(f32), bm.astype(f32), cm.astype(f32)
    b, s, g, e, p = xs.shape
    n = bm.shape[-1]
    c = s // CHUNK
    xs = xs.reshape(b, c, CHUNK, g, e, p)
    bm = bm.reshape(b, c, CHUNK, g, n)
    cm = cm.reshape(b, c, CHUNK, g, n)
    a = a.reshape(b, c, CHUNK, g, e).transpose(0, 3, 4, 1, 2)
    a_cs = jnp.cumsum(a, -1)
    lmat = segsum_exp(a)
    cb = jnp.einsum('bclgn,bcsgn->bgcls', cm, bm)
    y_diag = jnp.einsum('bgcls,bgecls,bcsgep->bclgep', cb, lmat, xs)
    decay_states = jnp.exp(a_cs[..., -1:] - a_cs)
    states = jnp.einsum('bclgn,bgecl,bclgep->bcgepn', bm, decay_states, xs)
    chunk_decay = jnp.exp(a_cs[..., -1])

    def step(h, inp):
        st, dec = inp
        return dec[..., None, None] * h + st, h

    h0 = jnp.zeros((b, g, e, p, n), f32)
    _, prev = lax.scan(step, h0, (states.transpose(1, 0, 2, 3, 4, 5),
                                  chunk_decay.transpose(3, 0, 1, 2)))
    prev = prev.transpose(1, 0, 2, 3, 4, 5)
    y_off = jnp.einsum('bclgn,bcgepn,bgecl->bclgep', cm, prev, jnp.exp(a_cs))
    return (y_diag + y_off).reshape(b, s, g, e, p)


def diff_attention(q, k, v, lam):
    b, s, nh, _, d = q.shape
    nblk = s // Q_BLOCK
    qb = q.reshape(b, nblk, Q_BLOCK, nh, 2, d).transpose(1, 0, 2, 3, 4, 5)
    key_pos = jnp.arange(s)

    def block(args):
        qi, i = args
        scores = jnp.einsum('bqhmd,bkhmd->bhmqk', qi, k, preferred_element_type=jnp.float32)
        q_pos = i * Q_BLOCK + jnp.arange(Q_BLOCK)
        mask = key_pos[None, :] <= q_pos[:, None]
        prob = jax.nn.softmax(jnp.where(mask, scores, -jnp.inf), axis=-1)
        w = prob[:, :, 0] - lam * prob[:, :, 1]
        return jnp.einsum('bhqk,bkhv->bqhv', w.astype(v.dtype), v)

    out = lax.map(block, (qb, jnp.arange(nblk)))
    return out.transpose(1, 0, 2, 3, 4).reshape(b, s, nh, v.shape[-1])


def hybrid_mixer(h, w_in, conv_w, conv_b, dt_bias, a_log, d_skip, ssd_norm_w,
                 lam_qk, attn_norm_w, w_out, lambda_init, cos, sin):
    b, s, _ = h.shape
    proj = h @ w_in
    offs = np.cumsum(IN_SPLITS)[:-1].tolist()
    z, xbc, dt, q, k, v = jnp.split(proj, offs, axis=-1)

    xbc = jax.nn.silu(causal_depthwise_conv(xbc, conv_w, conv_b))
    xs, bm, cm = jnp.split(xbc, [SSD_WIDTH, SSD_WIDTH + SSD_GROUPS * SSD_STATE], axis=-1)
    xs = xs.reshape(b, s, SSD_GROUPS, SSD_HEADS_PER_GROUP, SSD_HEADDIM)
    bm = bm.reshape(b, s, SSD_GROUPS, SSD_STATE)
    cm = cm.reshape(b, s, SSD_GROUPS, SSD_STATE)
    dt = jax.nn.softplus(dt.astype(jnp.float32) + dt_bias.astype(jnp.float32))
    dt = dt.reshape(b, s, SSD_GROUPS, SSD_HEADS_PER_GROUP)
    a_head = -jnp.exp(a_log.astype(jnp.float32)).reshape(SSD_GROUPS, SSD_HEADS_PER_GROUP)
    y = ssd_chunked(xs * dt[..., None], a_head * dt, bm, cm)
    y = y + d_skip.reshape(SSD_GROUPS, SSD_HEADS_PER_GROUP)[:, :, None] * xs
    y = y.reshape(b, s, SSD_WIDTH) * jax.nn.silu(z.astype(jnp.float32))
    y = rms_norm(y.reshape(b, s, SSD_GROUPS, SSD_WIDTH // SSD_GROUPS),
                 ssd_norm_w.reshape(SSD_GROUPS, SSD_WIDTH // SSD_GROUPS))
    y_ssd = y.reshape(b, s, SSD_WIDTH).astype(h.dtype)

    q = q.reshape(b, s, DIFF_HEADS, 2, DIFF_HEAD_DIM)
    k = k.reshape(b, s, DIFF_HEADS, 2, DIFF_HEAD_DIM)
    v = v.reshape(b, s, DIFF_HEADS, DIFF_V_DIM)
    q = (apply_rope(q, cos, sin) * (DIFF_HEAD_DIM ** -0.5)).astype(h.dtype)
    k = apply_rope(k, cos, sin).astype(h.dtype)
    lq = lam_qk.astype(jnp.float32)
    lam = jnp.exp(jnp.sum(lq[0] * lq[1])) - jnp.exp(jnp.sum(lq[2] * lq[3])) + lambda_init
    o = diff_attention(q, k, v, lam)
    o = rms_norm(o, attn_norm_w) * (1.0 - lambda_init)
    y_attn = o.reshape(b, s, ATTN_WIDTH).astype(h.dtype)

    return jnp.concatenate([y_ssd, y_attn], axis=-1) @ w_out


def swiglu(h, w_gate_up, w_down):
    g, u = jnp.split(h @ w_gate_up, 2, axis=-1)
    return (jax.nn.silu(g) * u) @ w_down


def setup_inputs(seed: int = 0) -> dict:
    key = jax.random.key(seed)
    ks = jax.random.split(key, 22)
    f32 = jnp.float32
    L = DEPTH

    def nrm(k, shape, scale):
        return jax.random.normal(k, shape, f32) * scale

    x = nrm(ks[0], (BATCH, SEQ, D_MODEL), 1.0)
    c = nrm(ks[1], (BATCH, D_MODEL), 1.0)
    w_mod = nrm(ks[2], (L, D_MODEL, N_MOD * D_MODEL), 0.01)
    b_mod = nrm(ks[3], (L, N_MOD * D_MODEL), 0.01)
    w_in = nrm(ks[4], (L, D_MODEL, D_IN_PROJ), D_MODEL ** -0.5)
    conv_w = nrm(ks[5], (L, CONV_WIDTH, SSD_XBC), CONV_WIDTH ** -0.5)
    conv_b = nrm(ks[6], (L, SSD_XBC), 0.02)
    dt0 = jnp.exp(jax.random.uniform(ks[7], (L, SSD_HEADS), f32, math.log(1e-3), math.log(1e-1)))
    dt_bias = dt0 + jnp.log(-jnp.expm1(-dt0))
    a_log = jnp.log(jax.random.uniform(ks[8], (L, SSD_HEADS), f32, 1.0, 16.0))
    d_skip = 1.0 + nrm(ks[9], (L, SSD_HEADS), 0.02)
    ssd_norm_w = 1.0 + nrm(ks[10], (L, SSD_WIDTH), 0.02)
    lam_qk = nrm(ks[11], (L, 4, DIFF_HEAD_DIM), 0.1)
    attn_norm_w = 1.0 + nrm(ks[12], (L, DIFF_V_DIM), 0.02)
    w_out = nrm(ks[13], (L, D_MIX, D_MODEL), BETA * D_MIX ** -0.5)
    ln1_g = 1.0 + nrm(ks[14], (L, D_MODEL), 0.02)
    ln1_b = nrm(ks[15], (L, D_MODEL), 0.02)
    w_gate_up = nrm(ks[16], (L, D_MODEL, 2 * D_FF), D_MODEL ** -0.5)
    w_down = nrm(ks[17], (L, D_FF, D_MODEL), BETA * D_FF ** -0.5)
    ln2_g = 1.0 + nrm(ks[18], (L, D_MODEL), 0.02)
    ln2_b = nrm(ks[19], (L, D_MODEL), 0.02)
    return {'x': x, 'c': c, 'w_mod': w_mod, 'b_mod': b_mod, 'w_in': w_in,
            'conv_w': conv_w, 'conv_b': conv_b, 'dt_bias': dt_bias, 'a_log': a_log,
            'd_skip': d_skip, 'ssd_norm_w': ssd_norm_w, 'lam_qk': lam_qk,
            'attn_norm_w': attn_norm_w, 'w_out': w_out, 'ln1_g': ln1_g, 'ln1_b': ln1_b,
            'w_gate_up': w_gate_up, 'w_down': w_down, 'ln2_g': ln2_g, 'ln2_b': ln2_b}


def reference(x, c, w_mod, b_mod, w_in, conv_w, conv_b, dt_bias, a_log, d_skip,
              ssd_norm_w, lam_qk, attn_norm_w, w_out, ln1_g, ln1_b, w_gate_up,
              w_down, ln2_g, ln2_b):
    cos, sin = rope_tables(x.shape[1], DIFF_HEAD_DIM)
    cond = jax.nn.silu(c)
    for l in range(DEPTH):
        mod = (cond @ w_mod[l] + b_mod[l])[:, None, :]
        shift1, scale1, gate1, shift2, scale2, gate2 = jnp.split(mod, N_MOD, axis=-1)
        lambda_init = 0.8 - 0.6 * math.exp(-0.3 * l)
        h = x * (1.0 + scale1) + shift1
        y = hybrid_mixer(h, w_in[l], conv_w[l], conv_b[l], dt_bias[l], a_log[l], d_skip[l],
                         ssd_norm_w[l], lam_qk[l], attn_norm_w[l], w_out[l],
                         lambda_init, cos, sin)
        x = layer_norm(ALPHA * x + (1.0 + gate1) * y, ln1_g[l], ln1_b[l])
        h = x * (1.0 + scale2) + shift2
        y = swiglu(h, w_gate_up[l], w_down[l])
        x = layer_norm(ALPHA * x + (1.0 + gate2) * y, ln2_g[l], ln2_b[l])
    return x
```

```cpp
#include <hip/hip_runtime.h>
#include <hip/hip_cooperative_groups.h>
#include <cstdio>
#include <cstdint>
namespace cg = cooperative_groups;
__device__ __forceinline__ int opaque_tid() { int t = threadIdx.x; asm volatile("" : "+v"(t)); return t; }
namespace pg8 {
#define PG8_LAS __attribute__((address_space(3)))
typedef unsigned short bf16_t;
typedef short bf16x8 __attribute__((ext_vector_type(8)));
typedef float f32x4 __attribute__((ext_vector_type(4)));
typedef unsigned u32x4 __attribute__((ext_vector_type(4)));
constexpr int BM = 256, BK = 64, HALF = 128, HTB = HALF * BK * 2  , STAGE_BYTES = 8 * HTB, NXCD = 8, WGM = 8;

__host__ __device__ __forceinline__ int lds_byte(int r, int c) { const int st = (r >> 4) * 2 + (c >> 5), rr = r & 15, cc = c & 31, ob = rr * 64 + cc * 2; return st * 1024 + (ob ^ (((ob >> 9) & 1) << 5)); }
__host__ __device__ __forceinline__ void stage_rc(int b, int& R, int& C) { const int st = b / 1024, sb = b % 1024, swz = sb ^ (((sb >> 9) & 1) << 5); R = (st >> 1) * 16 + swz / 64; C = (st & 1) * 32 + (swz % 64) / 2; }
__host__ __device__ __forceinline__ int perm32(int rho) { const int n = rho >> 4, i = rho & 15; return 8 * (i >> 2) + 4 * n + (i & 3); }

struct Unit { int pm, pn; };
struct Gemm { const bf16_t* A; const bf16_t* Bt; int M, N, K; };

struct StaticOrder {
    int nM, nN, nwg, G, c;
    __host__ __device__ void init(int M, int N, int G_, int c_) { nM = M / BM; nN = N / BM; nwg = nM * nN; G = G_; c = c_; }
    __host__ __device__ bool next(int i, Unit& u) const {
        const long L = (long)i * G + c; if (L >= nwg) return false;
        int wgid = (int)L; { const int q = nwg / NXCD, r = nwg % NXCD, xcd = wgid % NXCD, off = wgid / NXCD; wgid = (xcd < r ? xcd * (q + 1) : r * (q + 1) + (xcd - r) * q) + off; }
        const int nig = WGM * nN, gid = wgid / nig, fm = gid * WGM, gsz = (nM - fm) < WGM ? (nM - fm) : WGM;
        u.pm = fm + ((wgid % nig) % gsz); u.pn = (wgid % nig) / gsz; return true;
    }
    __device__ __forceinline__ void a_ready(const Unit&) const {}
    __device__ __forceinline__ void done(const Unit&) const {}
};

__device__ __forceinline__ unsigned cvt_pk_bf16(float lo, float hi) { unsigned r; asm volatile("v_cvt_pk_bf16_f32 %0, %1, %2" : "=v"(r) : "v"(lo), "v"(hi)); return r; }
typedef float f32x2 __attribute__((ext_vector_type(2)));
__device__ __forceinline__ f32x2 gelu_pk(f32x2 v) {
    const f32x2 av = __builtin_elementwise_abs(v), d = av * 0.2316418882f + 1.0f;
    f32x2 t; t.x = __builtin_amdgcn_rcpf(d.x); t.y = __builtin_amdgcn_rcpf(d.y);
    f32x2 q = t * 0.5307027145f + (-0.7265760135f); q = q * t + 0.7107068705f; q = q * t + (-0.142248368f); q = q * t + 0.127414796f; q = q * t;
    const f32x2 s = (v * v) * (-0.72134752044f);
    f32x2 e; e.x = __builtin_amdgcn_exp2f(s.x); e.y = __builtin_amdgcn_exp2f(s.y);
    const f32x2 m = v * (q * e), r = v - m;
    f32x2 o; o.x = v.x < 0.f ? m.x : r.x; o.y = v.y < 0.f ? m.y : r.y; return o;
}

template <int ACT  > struct EpiBf16 {
    static constexpr bool PERM = true, AFTER_DRAIN = false; static_assert(ACT == 0 || ACT == 1, "EpiBf16: ACT is 0 (none) or 1 (gelu_pk)");
    bf16_t* O; int ldc; const float* bias; int split_cols; size_t split_stride; float scale0;
    __device__ __forceinline__ void operator()(const f32x4 (&acc)[2][2][4][2], const Unit& u, int wr, int wc, int fr, int fq) const {
        const int row0 = u.pm * BM + wr * 64 + fr; int colt = u.pn * BM; bf16_t* base = O;
        float sc = 1.f; if (split_cols) { const int t = colt / split_cols; base += (size_t)t * split_stride; colt -= t * split_cols; if (t == 0) sc = scale0; }
        const int col0 = colt + wc * 32 + 8 * fq, bcol0 = u.pn * BM + wc * 32 + 8 * fq;
        f32x4 bv[2][2];
#pragma unroll
        for (int bj = 0; bj < 2; ++bj)
#pragma unroll
            for (int n = 0; n < 2; ++n) bv[bj][n] = bias ? *(const f32x4*)(bias + bcol0 + bj * HALF + 4 * n) : (f32x4){0.f, 0.f, 0.f, 0.f};
#pragma unroll
        for (int ai = 0; ai < 2; ++ai)
#pragma unroll
            for (int m = 0; m < 4; ++m) { bf16_t* rowp = base + (size_t)(row0 + ai * HALF + m * 16) * ldc + col0;
#pragma unroll
                for (int bj = 0; bj < 2; ++bj) { f32x4 v0 = acc[ai][bj][m][0] + bv[bj][0], v1 = acc[ai][bj][m][1] + bv[bj][1];
                    if (ACT == 1) { f32x2 a = gelu_pk((f32x2){v0[0], v0[1]}), b = gelu_pk((f32x2){v0[2], v0[3]}), c = gelu_pk((f32x2){v1[0], v1[1]}), d = gelu_pk((f32x2){v1[2], v1[3]});
                        v0 = (f32x4){a.x, a.y, b.x, b.y}; v1 = (f32x4){c.x, c.y, d.x, d.y}; }
                    v0 = v0 * sc; v1 = v1 * sc; u32x4 w; w.x = cvt_pk_bf16(v0[0], v0[1]); w.y = cvt_pk_bf16(v0[2], v0[3]); w.z = cvt_pk_bf16(v1[0], v1[1]); w.w = cvt_pk_bf16(v1[2], v1[3]);
                    *(u32x4*)(rowp + bj * HALF) = w; } }
    }
};
typedef float f32x2e __attribute__((ext_vector_type(2)));
typedef unsigned u32x2e __attribute__((ext_vector_type(2)));
struct EpiInProj {
    static constexpr bool PERM = true, AFTER_DRAIN = false;
    bf16_t* O; int ldc; const float* rope; float qscale;
    __device__ __forceinline__ void operator()(const f32x4 (&acc)[2][2][4][2], const Unit& u, int wr, int wc, int fr, int fq) const {
        const int row0 = u.pm * BM + wr * 64 + fr; const int colt = u.pn * BM;
        const int col0 = colt + wc * 32 + 8 * fq;
        const bool is_q = (u.pn == 6 || u.pn == 7), is_k = (u.pn == 8 || u.pn == 9);
        const float sc = is_q ? qscale : 1.f;
        const int j0 = 16 * (wc & 1) + 4 * fq;
#pragma unroll
        for (int ai = 0; ai < 2; ++ai)
#pragma unroll
            for (int m = 0; m < 4; ++m) { const int row = row0 + ai * HALF + m * 16; bf16_t* rowp = O + (size_t)row * ldc + col0;
                f32x4 r0 = (f32x4){1.f, 0.f, 1.f, 0.f}, r1 = r0;
                if (is_q || is_k) { const float* rp = rope + ((size_t)(row & 8191) * 32 + j0) * 2; r0 = *(const f32x4*)rp; r1 = *(const f32x4*)(rp + 4); }
#pragma unroll
                for (int bj = 0; bj < 2; ++bj) { f32x4 v0 = acc[ai][bj][m][0], v1 = acc[ai][bj][m][1];
                    if (is_q || is_k) {
                        f32x4 o0, o1;
                        o0[0] = v0[0] * r0[0] - v0[1] * r0[1]; o0[1] = v0[1] * r0[0] + v0[0] * r0[1];
                        o0[2] = v0[2] * r0[2] - v0[3] * r0[3]; o0[3] = v0[3] * r0[2] + v0[2] * r0[3];
                        o1[0] = v1[0] * r1[0] - v1[1] * r1[1]; o1[1] = v1[1] * r1[0] + v1[0] * r1[1];
                        o1[2] = v1[2] * r1[2] - v1[3] * r1[3]; o1[3] = v1[3] * r1[2] + v1[2] * r1[3];
                        v0 = o0 * sc; v1 = o1 * sc; }
                    u32x4 w; w.x = cvt_pk_bf16(v0[0], v0[1]); w.y = cvt_pk_bf16(v0[2], v0[3]); w.z = cvt_pk_bf16(v1[0], v1[1]); w.w = cvt_pk_bf16(v1[2], v1[3]);
                    *(u32x4*)(rowp + bj * HALF) = w; } }
    }
};
struct EpiSwiGLU {
    static constexpr bool PERM = true, AFTER_DRAIN = false;
    bf16_t* O; int ldo;
    __device__ __forceinline__ void operator()(const f32x4 (&acc)[2][2][4][2], const Unit& u, int wr, int wc, int fr, int fq) const {
        const int row0 = u.pm * BM + wr * 64 + fr; const int i0 = u.pn * (BM / 2) + wc * 16 + 4 * fq;
#pragma unroll
        for (int ai = 0; ai < 2; ++ai)
#pragma unroll
            for (int m = 0; m < 4; ++m) { bf16_t* rowp = O + (size_t)(row0 + ai * HALF + m * 16) * ldo + i0;
#pragma unroll
                for (int bj = 0; bj < 2; ++bj) { const f32x4 v0 = acc[ai][bj][m][0], v1 = acc[ai][bj][m][1];
                    float g[4] = {v0[0], v0[2], v1[0], v1[2]}, uu[4] = {v0[1], v0[3], v1[1], v1[3]}, o[4];
#pragma unroll
                    for (int e = 0; e < 4; ++e) o[e] = g[e] * __builtin_amdgcn_rcpf(1.f + __builtin_amdgcn_exp2f(-1.4426950408889634f * g[e])) * uu[e];
                    u32x2e w; w.x = cvt_pk_bf16(o[0], o[1]); w.y = cvt_pk_bf16(o[2], o[3]);
                    *(u32x2e*)(rowp + bj * (HALF / 2)) = w; } }
    }
};
struct EpiF32 {
    static constexpr bool PERM = false, AFTER_DRAIN = false;
    float* O; int ldc;
    __device__ __forceinline__ void operator()(const f32x4 (&acc)[2][2][4][2], const Unit& u, int wr, int wc, int fr, int fq) const {
        const int row0 = u.pm * BM + wr * 64 + fr; const int col0 = u.pn * BM + wc * 32 + 4 * fq;
#pragma unroll
        for (int ai = 0; ai < 2; ++ai)
#pragma unroll
            for (int m = 0; m < 4; ++m) { float* rowp = O + (size_t)(row0 + ai * HALF + m * 16) * ldc + col0;
#pragma unroll
                for (int bj = 0; bj < 2; ++bj)
#pragma unroll
                    for (int n = 0; n < 2; ++n) *(f32x4*)(rowp + bj * HALF + n * 16) = acc[ai][bj][m][n]; }
    }
};
template <class Epi, class Sched, bool ALIGN_EPI = false, bool SP2 = false>
__device__ __forceinline__ void gemm_phase(PG8_LAS unsigned char* lds, const Gemm g, const Sched& S, const Epi& E) {
    const int tid = opaque_tid(), wid = __builtin_amdgcn_readfirstlane(tid >> 6), lane = tid & 63, wr = wid >> 2, wc = wid & 3, fr = lane & 15, fq = lane >> 4;
    const int K = g.K, nt = K / BK;
    unsigned voffA[2], voffB[2];
#pragma unroll
    for (int i = 0; i < 2; ++i) { int R, C; stage_rc(tid * 16 + i * 8192, R, C); const int Rb = Epi::PERM ? ((R & ~31) + perm32(R & 31)) : R;
        voffA[i] = (unsigned)(R * K + C) * 2u; voffB[i] = (unsigned)(Rb * K + C) * 2u; }
    const size_t kstep = (size_t)(BK * 2);
    const size_t hstep = (size_t)HALF * K * 2;
    const size_t tstep = 2 * hstep;
    const unsigned ldsw = (unsigned)wid * 1024u;
    const int aoff = lds_byte(wr * 64 + fr, fq * 8), boff = lds_byte(wc * 32 + fr, fq * 8);
#define PG8_SA(b, h) (((b) * 2 + (h)) * HTB)
#define PG8_SB(b, h) ((4 + (b) * 2 + (h)) * HTB)
#define PG8_STAGE(bufoff, gbase, voff) do { _Pragma("unroll") for (int _i = 0; _i < 2; ++_i) \
        __builtin_amdgcn_global_load_lds((const unsigned*)((const char*)(gbase) + (voff)[_i]), (PG8_LAS unsigned*)(lds + (bufoff) + ldsw + _i * 8192), 16, 0, 0); } while (0)
#define PG8_LDA(dst, b, h) do { _Pragma("unroll") for (int m = 0; m < 4; ++m) _Pragma("unroll") for (int k = 0; k < 2; ++k) dst[m][k] = *(const PG8_LAS bf16x8*)(lds + PG8_SA(b, h) + aoff + m * 2048 + k * 1024); } while (0)
#define PG8_LDB(dst, b, h) do { _Pragma("unroll") for (int n = 0; n < 2; ++n) _Pragma("unroll") for (int k = 0; k < 2; ++k) dst[n][k] = *(const PG8_LAS bf16x8*)(lds + PG8_SB(b, h) + boff + n * 2048 + k * 1024); } while (0)
#define PG8_MMA(ai, bj, At, Bt) do { __builtin_amdgcn_s_setprio(1); _Pragma("unroll") for (int m = 0; m < 4; ++m) _Pragma("unroll") for (int n = 0; n < 2; ++n) _Pragma("unroll") for (int k = 0; k < 2; ++k) \
        acc[ai][bj][m][n] = __builtin_amdgcn_mfma_f32_16x16x32_bf16(Bt[n][k], At[m][k], acc[ai][bj][m][n], 0, 0, 0); __builtin_amdgcn_s_setprio(0); } while (0)
#define PG8_WAIT_V(n) asm volatile("s_waitcnt vmcnt(" #n ")" ::: "memory")
#define PG8_WAIT_L(n) asm volatile("s_waitcnt lgkmcnt(" #n ")" ::: "memory")
#define PG8_BAR __builtin_amdgcn_s_barrier()
#define PG8_SCHED __builtin_amdgcn_sched_barrier(0)
    Unit cur, nxt; int ui = 0;
    if (!S.next(0, cur)) return;
    f32x4 acc[2][2][4][2];
#pragma unroll
    for (int a = 0; a < 2; ++a)
#pragma unroll
        for (int b = 0; b < 2; ++b)
#pragma unroll
            for (int m = 0; m < 4; ++m)
#pragma unroll
                for (int n = 0; n < 2; ++n) acc[a][b][m][n] = (f32x4){0.f, 0.f, 0.f, 0.f};
    bf16x8 At[4][2], B0[2][2], B1[2][2];
    const char* cA = (const char*)g.A + (size_t)cur.pm * tstep; const char* cB = (const char*)g.Bt + (size_t)cur.pn * tstep;
    S.a_ready(cur);
    if constexpr (SP2) {
        PG8_STAGE(PG8_SB(0, 0), cB, voffB); PG8_STAGE(PG8_SB(0, 1), cB + hstep, voffB); PG8_STAGE(PG8_SA(0, 0), cA, voffA); PG8_STAGE(PG8_SA(0, 1), cA + hstep, voffA);
        if (wr == 1) PG8_BAR;
        PG8_WAIT_V(2); PG8_BAR;
        PG8_STAGE(PG8_SB(1, 0), cB + kstep, voffB); PG8_STAGE(PG8_SA(1, 0), cA + kstep, voffA); PG8_STAGE(PG8_SB(1, 1), cB + hstep + kstep, voffB);
        PG8_WAIT_V(6); PG8_BAR;
    } else {
        PG8_STAGE(PG8_SB(0, 0), cB, voffB); PG8_STAGE(PG8_SA(0, 0), cA, voffA); PG8_STAGE(PG8_SB(0, 1), cB + hstep, voffB); PG8_STAGE(PG8_SA(0, 1), cA + hstep, voffA);
        if (wr == 1) PG8_BAR;
        PG8_WAIT_V(4); PG8_BAR;
        PG8_STAGE(PG8_SB(1, 0), cB + kstep, voffB); PG8_STAGE(PG8_SA(1, 0), cA + kstep, voffA); PG8_STAGE(PG8_SB(1, 1), cB + hstep + kstep, voffB);
        PG8_WAIT_V(6); PG8_BAR;
    }
    for (;;) {
        const bool has_next = S.next(ui + 1, nxt);
        const char* nA = has_next ? (const char*)g.A + (size_t)nxt.pm * tstep : cA; const char* nB = has_next ? (const char*)g.Bt + (size_t)nxt.pn * tstep : cB;
        for (int t = 0; t < nt; t += 2) {
            const bool last = (t == nt - 2);
            const char* a1 = cA + (size_t)(t + 1) * kstep;
            const char* a2 = last ? nA : cA + (size_t)(t + 2) * kstep; const char* b2 = last ? nB : cB + (size_t)(t + 2) * kstep;
            const char* a3 = a2 + kstep; const char* b3 = b2 + kstep;
            if (last && has_next) S.a_ready(nxt);
            if constexpr (SP2) {
            PG8_LDB(B0, 0, 0); PG8_LDB(B1, 0, 1); PG8_SCHED; PG8_LDA(At, 0, 0); PG8_STAGE(PG8_SA(1, 1), a1 + hstep, voffA);
            PG8_WAIT_V(8); PG8_WAIT_L(0); PG8_BAR; PG8_MMA(0, 0, At, B0); PG8_MMA(0, 1, At, B1); PG8_BAR; PG8_SCHED;
            PG8_LDA(At, 0, 1); PG8_STAGE(PG8_SB(0, 0), b2, voffB); PG8_STAGE(PG8_SB(0, 1), b2 + hstep, voffB); PG8_STAGE(PG8_SA(0, 0), a2, voffA);
            PG8_WAIT_V(8); PG8_WAIT_L(0); PG8_BAR; PG8_MMA(1, 0, At, B0); PG8_MMA(1, 1, At, B1); PG8_BAR; PG8_SCHED;
            PG8_LDB(B0, 1, 0); PG8_LDB(B1, 1, 1); PG8_SCHED; PG8_LDA(At, 1, 0); PG8_STAGE(PG8_SA(0, 1), a2 + hstep, voffA);
            PG8_WAIT_V(8); PG8_WAIT_L(0); PG8_BAR; PG8_MMA(0, 0, At, B0); PG8_MMA(0, 1, At, B1); PG8_BAR; PG8_SCHED;
            PG8_LDA(At, 1, 1); PG8_STAGE(PG8_SB(1, 0), b3, voffB); PG8_STAGE(PG8_SB(1, 1), b3 + hstep, voffB); PG8_STAGE(PG8_SA(1, 0), a3, voffA);
            PG8_WAIT_V(8); PG8_WAIT_L(0); PG8_BAR; PG8_MMA(1, 0, At, B0); PG8_MMA(1, 1, At, B1); PG8_BAR; PG8_SCHED;
            } else {
            PG8_LDB(B0, 0, 0); PG8_SCHED; PG8_LDA(At, 0, 0); PG8_STAGE(PG8_SA(1, 1), a1 + hstep, voffA);
            PG8_WAIT_L(8); PG8_BAR; PG8_WAIT_L(0); PG8_MMA(0, 0, At, B0); PG8_BAR; PG8_SCHED;
            PG8_LDB(B1, 0, 1); PG8_STAGE(PG8_SB(0, 0), b2, voffB);
            PG8_BAR; PG8_WAIT_L(0); PG8_MMA(0, 1, At, B1); PG8_BAR;
            PG8_LDA(At, 0, 1); PG8_STAGE(PG8_SA(0, 0), a2, voffA);
            PG8_BAR; PG8_WAIT_L(0); PG8_MMA(1, 0, At, B0); PG8_BAR; PG8_SCHED;
            PG8_STAGE(PG8_SB(0, 1), b2 + hstep, voffB);
            PG8_WAIT_V(6); PG8_BAR; PG8_MMA(1, 1, At, B1); PG8_BAR;
            PG8_LDB(B0, 1, 0); PG8_SCHED; PG8_LDA(At, 1, 0); PG8_STAGE(PG8_SA(0, 1), a2 + hstep, voffA);
            PG8_WAIT_L(8); PG8_BAR; PG8_WAIT_L(0); PG8_MMA(0, 0, At, B0); PG8_BAR; PG8_SCHED;
            PG8_LDB(B1, 1, 1); PG8_STAGE(PG8_SB(1, 0), b3, voffB);
            PG8_BAR; PG8_WAIT_L(0); PG8_MMA(0, 1, At, B1); PG8_BAR;
            PG8_LDA(At, 1, 1); PG8_STAGE(PG8_SA(1, 0), a3, voffA);
            PG8_BAR; PG8_WAIT_L(0); PG8_MMA(1, 0, At, B0); PG8_BAR; PG8_SCHED;
            PG8_STAGE(PG8_SB(1, 1), b3 + hstep, voffB);
            PG8_WAIT_V(6); PG8_BAR; PG8_MMA(1, 1, At, B1); PG8_BAR;
            }
        }
        if constexpr (ALIGN_EPI) { if (wr == 0) PG8_BAR; }
        if constexpr (!Epi::AFTER_DRAIN) { E(acc, cur, wr, wc, fr, fq); S.done(cur); }
        if (!has_next) break;
#pragma unroll
        for (int a = 0; a < 2; ++a)
#pragma unroll
            for (int b = 0; b < 2; ++b)
#pragma unroll
                for (int m = 0; m < 4; ++m)
#pragma unroll
                    for (int n = 0; n < 2; ++n) acc[a][b][m][n] = (f32x4){0.f, 0.f, 0.f, 0.f};
        cur = nxt; cA = nA; cB = nB; ++ui;
        if constexpr (ALIGN_EPI) { if (wr == 1) PG8_BAR; }
    }
    PG8_WAIT_V(0);
    if constexpr (!ALIGN_EPI) { if (wr == 0) PG8_BAR; }
    PG8_BAR;
    if constexpr (Epi::AFTER_DRAIN) { E.fused(acc, cur, wr, wc, fr, fq, lds, wid, lane); S.done(cur); }
#undef PG8_SA
#undef PG8_SB
#undef PG8_STAGE
#undef PG8_LDA
#undef PG8_LDB
#undef PG8_MMA
#undef PG8_WAIT_V
#undef PG8_WAIT_L
#undef PG8_BAR
#undef PG8_SCHED
}
}
#define PG8_SP2 true
#include <hip/hip_bf16.h>
#include <cmath>
namespace attn_body {
using bf16=__hip_bfloat16;
using bf16x8=__attribute__((ext_vector_type(8)))short;
using s16x4=__attribute__((ext_vector_type(4)))short;
using f32x16=__attribute__((ext_vector_type(16)))float;
using u32x4=__attribute__((ext_vector_type(4)))unsigned;
constexpr int BATCH=2,NHEAD=16,SEQ=8192,D=64,DM=3328,PO=1024;
constexpr int NW=8,QBLK=32,QB=QBLK*NW,KVBLK=64,NQB=SEQ/QB;
constexpr int ATTN_PITCH=DM, ATTN_UNIT_ROWS=QB;
__device__ __forceinline__ int crow(int r,int hi){return (r&3)+8*(r>>2)+4*hi;}
#define SBAR() __builtin_amdgcn_sched_barrier(0)
__device__ __forceinline__ void cmask(f32x16&p0,f32x16&p1,int jb,int qrel,int hi){
  const float NEG=-INFINITY; int kb=64*jb+4*hi;
  #pragma unroll
  for(int r=0;r<16;++r){int kv=kb+(r&3)+8*(r>>2); if(kv>qrel)p0[r]=NEG; if(kv+32>qrel)p1[r]=NEG;}
}

constexpr int NSLOT=3, SLOTB=8192;
constexpr int LDS_K=0, LDS_V=NSLOT*SLOTB, LDS_WS=2*NSLOT*SLOTB, LDS_OST=LDS_WS+NW*64*4, LDS_BYTES=LDS_OST+NW*4096;
constexpr float C2=0.125f*1.4426950408889634f;
__device__ __forceinline__ void glds16(const void*gsrc,unsigned lds_dst){unsigned keep;
  asm volatile("s_mov_b32 %0, m0\n\ts_mov_b32 m0, %2\n\ts_nop 0\n\tglobal_load_lds_dwordx4 %1, off\n\ts_mov_b32 m0, %0":"=&s"(keep):"v"(gsrc),"s"(lds_dst):"memory");}
__device__ __forceinline__ float max3f(float a,float b,float c){float r;asm("v_max3_f32 %0, %1, %2, %3":"=v"(r):"v"(a),"v"(b),"v"(c));return r;}
__device__ __forceinline__ float max2f(float a,float b){float r;asm("v_max_f32_e32 %0, %1, %2":"=v"(r):"v"(a),"v"(b));return r;}
__device__ __forceinline__ float fadd_s(float a,float b){float r;asm("v_add_f32_e32 %0, %1, %2":"=v"(r):"v"(a),"v"(b));return r;}
__device__ __forceinline__ float fsub_s(float a,float b){float r;asm("v_sub_f32_e32 %0, %1, %2":"=v"(r):"v"(a),"v"(b));return r;}
typedef float f32x2_t __attribute__((ext_vector_type(2))); typedef __bf16 bf16x2_t __attribute__((ext_vector_type(2)));
__device__ __forceinline__ unsigned cvtpk_s(float lo,float hi){f32x2_t v={lo,hi};bf16x2_t b=__builtin_convertvector(v,bf16x2_t);return __builtin_bit_cast(unsigned,b);}
#define WAIT_BAR(N) asm volatile("s_waitcnt vmcnt(" #N ") lgkmcnt(0)\n\ts_barrier":::"memory")

__device__ __forceinline__ void qkt(f32x16&p0,f32x16&p1,const char*Kslot,const bf16x8*qr,const f32x16&negm,int r32,int hi){
  const char*kb=Kslot+hi*1024+r32*16;
  #pragma unroll
  for(int d0=0;d0<4;++d0){
    const bf16x8 b0=*reinterpret_cast<const bf16x8*>(kb+d0*2048);
    const bf16x8 b1=*reinterpret_cast<const bf16x8*>(kb+d0*2048+512);
    if(d0==0){p0=__builtin_amdgcn_mfma_f32_32x32x16_bf16(b0,qr[0],negm,0,0,0);p1=__builtin_amdgcn_mfma_f32_32x32x16_bf16(b1,qr[0],negm,0,0,0);}
    else{p0=__builtin_amdgcn_mfma_f32_32x32x16_bf16(b0,qr[d0],p0,0,0,0);p1=__builtin_amdgcn_mfma_f32_32x32x16_bf16(b1,qr[d0],p1,0,0,0);}}
}
typedef __attribute__((address_space(3))) const char* lds_cptr;
typedef short v4i16_t __attribute__((ext_vector_type(4)));
__device__ __forceinline__ void kload8(bf16x8*kf,lds_cptr kp){
  kf[0]=*(const __attribute__((address_space(3))) bf16x8*)(kp);      kf[1]=*(const __attribute__((address_space(3))) bf16x8*)(kp+512);
  kf[2]=*(const __attribute__((address_space(3))) bf16x8*)(kp+2048); kf[3]=*(const __attribute__((address_space(3))) bf16x8*)(kp+2560);
  kf[4]=*(const __attribute__((address_space(3))) bf16x8*)(kp+4096); kf[5]=*(const __attribute__((address_space(3))) bf16x8*)(kp+4608);
  kf[6]=*(const __attribute__((address_space(3))) bf16x8*)(kp+6144); kf[7]=*(const __attribute__((address_space(3))) bf16x8*)(kp+6656);
}
__device__ __forceinline__ void kload2(bf16x8*kf,lds_cptr kp,int j){ kf[2*j]=*(const __attribute__((address_space(3))) bf16x8*)(kp+j*2048); kf[2*j+1]=*(const __attribute__((address_space(3))) bf16x8*)(kp+j*2048+512); }
__device__ __forceinline__ s16x4 vtr(lds_cptr p){ return __builtin_bit_cast(s16x4,__builtin_amdgcn_ds_read_tr16_b64_v4i16((__attribute__((address_space(3))) v4i16_t*)p)); }
__device__ __forceinline__ float rowmax(const f32x16&p0,const f32x16&p1){
  float a=max3f(p0[0],p0[1],p1[0]),b=max3f(p0[2],p0[3],p1[1]);a=max3f(a,p1[2],p1[3]);
  #pragma unroll
  for(int r=4;r<16;r+=4){a=max3f(a,p0[r],p0[r+1]);b=max3f(b,p0[r+2],p0[r+3]);a=max3f(a,p1[r],p1[r+1]);b=max3f(b,p1[r+2],p1[r+3]);}
  const float m=max2f(a,b);
  auto rr=__builtin_amdgcn_permlane32_swap(__float_as_uint(m),__float_as_uint(m),false,false);
  return max2f(__uint_as_float(rr[0]),__uint_as_float(rr[1]));
}
__device__ __forceinline__ void pv(f32x16*o,int vb,bf16x8 pa0,bf16x8 pa1,bf16x8 pa2,bf16x8 pa3){
  #pragma unroll
  for(int d0=0;d0<2;++d0){s16x4 lo[4],hi[4];
    #pragma unroll
    for(int ks=0;ks<4;++ks){
      asm volatile("ds_read_b64_tr_b16 %0,%1 offset:%c2":"=&v"(lo[ks]):"v"(vb),"i"(d0*4096+ks*1024):"memory");
      asm volatile("ds_read_b64_tr_b16 %0,%1 offset:%c2":"=&v"(hi[ks]):"v"(vb),"i"(d0*4096+ks*1024+512):"memory");}
    asm volatile("s_waitcnt lgkmcnt(0)":::"memory");SBAR();
    #define PK(k) (bf16x8){lo[k][0],lo[k][1],lo[k][2],lo[k][3],hi[k][0],hi[k][1],hi[k][2],hi[k][3]}
    o[d0]=__builtin_amdgcn_mfma_f32_32x32x16_bf16(pa0,PK(0),o[d0],0,0,0);
    o[d0]=__builtin_amdgcn_mfma_f32_32x32x16_bf16(pa1,PK(1),o[d0],0,0,0);
    o[d0]=__builtin_amdgcn_mfma_f32_32x32x16_bf16(pa2,PK(2),o[d0],0,0,0);
    o[d0]=__builtin_amdgcn_mfma_f32_32x32x16_bf16(pa3,PK(3),o[d0],0,0,0);
    #undef PK
  }
}

#ifndef ATTN_STORE16
#define ATTN_STORE16(p,v) (*(u32x4*)(p)=(v))
#endif
template<int THRL> __device__ __forceinline__ void attn_unit(int b,int qb,const bf16*Q,const bf16*__restrict__ K,const bf16*__restrict__ V,bf16*O,char*shm){
  const int tid=opaque_tid(),lane=tid&63,r32=lane&31,hi=lane>>5; const int wid=__builtin_amdgcn_readfirstlane(tid>>6);
  const long rowbase=(long)b*SEQ; const int q0=qb*QB;
  const bf16*Qw=Q+(rowbase+q0+wid*QBLK)*DM;
  const bf16*Kh=K+rowbase*DM,*Vh=V+rowbase*DM;
  const unsigned lds0=(unsigned)(uintptr_t)shm;
  float*wsf=(float*)(shm+LDS_WS)+wid*64;
  const bf16*ksrc=Kh+(long)lane*DM+wid*8;
  const bf16*vsrc=Vh+(long)(16*(wid&3)+(lane>>2))*DM+(wid>>2)*32+(lane&3)*8;
  const unsigned kdst=lds0+LDS_K+wid*1024, vdst=lds0+LDS_V+wid*1024;
  #define DMA_K(t,slot) glds16(ksrc+(long)(t)*KVBLK*DM,(unsigned)__builtin_amdgcn_readfirstlane(kdst+(slot)))
  #define DMA_V(t,slot) glds16(vsrc+(long)(t)*KVBLK*DM,(unsigned)__builtin_amdgcn_readfirstlane(vdst+(slot)))
  const int vb0=(int)(lds0+LDS_V)+((lane>>4)&1)*32+(lane&3)*8+(4*hi+((lane&15)>>2))*64;
  const char*Kbase=shm+LDS_K; bf16x8 kf[8];
  const lds_cptr shm3=(lds_cptr)shm; const lds_cptr kp0=shm3+LDS_K+hi*1024+r32*16; const lds_cptr vp0=shm3+LDS_V+((lane>>4)&1)*32+(lane&3)*8+(4*hi+((lane&15)>>2))*64;
  const int NT=(q0+QB)/KVBLK;
  DMA_K(0,0);DMA_V(0,0);DMA_K(1,SLOTB);
  bf16x8 qr[4];
  #pragma unroll
  for(int d0=0;d0<4;++d0)qr[d0]=*reinterpret_cast<const bf16x8*>(&Qw[(long)r32*DM+d0*16+hi*8]);
  float mhat=0.f,l_reg=0.f;f32x16 o[2];o[0]=f32x16{};o[1]=f32x16{};f32x16 negm=f32x16{};asm volatile("":"+v"(negm));
  const int qrel=wid*QBLK+r32;
  #define CMASK(P0,P1,t) do{int jb_=(t)-(NT-4); if(jb_>=0)cmask(P0,P1,jb_,qrel,hi);}while(0)
  bool resc=false;
  #define START(P0,P1) do{ const float rm=rowmax(P0,P1); resc=false; \
    { const float dl=rm; mhat=fadd_s(mhat,dl); \
      _Pragma("unroll") for(int r=0;r<16;++r){P0[r]=fsub_s(P0[r],dl);P1[r]=fsub_s(P1[r],dl);} \
      _Pragma("unroll") for(int r=0;r<16;++r)negm[r]=-mhat; asm volatile("":"+v"(negm)); } \
    _Pragma("unroll") for(int r=0;r<16;++r)P0[r]=__builtin_amdgcn_exp2f(P0[r]); }while(0)
  #define RESC() do{ if(resc){ asm volatile("s_waitcnt lgkmcnt(0)":::"memory"); \
      _Pragma("unroll") for(int d_=0;d_<2;++d_) _Pragma("unroll") for(int r=0;r<16;++r)o[d_][r]*=wsf[crow(r,hi)]; } }while(0)
  f32x16 pA0,pA1,pB0,pB1;
  int sl_prev=0,sl_cur=0,sl_next=SLOTB;
  #define ROT() do{sl_prev=sl_cur;sl_cur=sl_next;sl_next=(sl_next==(NSLOT-1)*SLOTB)?0:sl_next+SLOTB;}while(0)
  DMA_K(2,2*SLOTB);
  WAIT_BAR(3);
  qkt(pA0,pA1,Kbase,qr,negm,r32,hi);asm volatile("s_nop 15\n\ts_nop 7":"+v"(pA0),"+v"(pA1));CMASK(pA0,pA1,0);
  START(pA0,pA1);
  _Pragma("unroll") for(int r=0;r<16;++r)pA1[r]=__builtin_amdgcn_exp2f(pA1[r]);
  WAIT_BAR(0);
  DMA_K(3,0);DMA_V(1,SLOTB);
  ROT();
  kload8(kf,kp0+sl_cur);
  WAIT_BAR(2);
  s16x4 vlo[8],vhi[8]; u32x4 pw0,pw1,pw2,pw3;
  #define PKW(P,B) cvtpk_s(P[B],P[B+1])
  #define PAF(k) __builtin_bit_cast(bf16x8,pw##k)
  #define VFR(i) (bf16x8){vlo[i][0],vlo[i][1],vlo[i][2],vlo[i][3],vhi[i][0],vhi[i][1],vhi[i][2],vhi[i][3]}
  #define PIN(x) asm volatile("":"+v"(x))
  #define MX3(a,b,c) __builtin_fmaxf(__builtin_fmaxf((a),(b)),(c))
  #define GAPA(MF,A0,A1,A2,A3,W0,W1,PW) do{ MF; sacc+=A0; sacc+=A1; sacc+=A2; sacc+=A3; PIN(sacc); W0; W1; PIN(PW); SBAR(); }while(0)
  #define EX(v) __builtin_amdgcn_exp2f(v)
  #define GAPB(MF,X,B) do{ MF; X[B]=EX(X[B]); X[B+1]=EX(X[B+1]); X[B+2]=EX(X[B+2]); X[B+3]=EX(X[B+3]); PIN(X); SBAR(); }while(0)
  #define VRD(i) do{ vlo[i]=vtr(vp_+(((i)>>2)*4096+((i)&3)*1024)); vhi[i]=vtr(vp_+(((i)>>2)*4096+((i)&3)*1024+512)); }while(0)
  #define KRD(G,j) do{ if(G){ kload2(kf,kp0+sl_next,j); SBAR(); } }while(0)
  #define STEP(C0,C1,P0,P1,t,GK,GV,GL) do{ SBAR(); \
    const lds_cptr vp_=vp0+sl_prev; \
    VRD(0); SBAR(); float sacc=(P0[0]+P0[1]); \
    GAPA(C0=__builtin_amdgcn_mfma_f32_32x32x16_bf16(kf[0],qr[0],negm,0,0,0), P0[2],P0[3],P0[4],P0[5],     pw0[0]=PKW(P0,0), pw0[1]=PKW(P0,2), pw0); \
    VRD(4); SBAR(); GAPA(C1=__builtin_amdgcn_mfma_f32_32x32x16_bf16(kf[1],qr[0],negm,0,0,0), P0[6],P0[7],P0[8],P0[9],     pw0[2]=PKW(P0,4), pw0[3]=PKW(P0,6), pw0); \
    VRD(1); SBAR(); GAPA(C0=__builtin_amdgcn_mfma_f32_32x32x16_bf16(kf[2],qr[1],C0,0,0,0),   P0[10],P0[11],P0[12],P0[13], pw1[0]=PKW(P0,8), pw1[1]=PKW(P0,10), pw1); \
    VRD(5); SBAR(); GAPA(C1=__builtin_amdgcn_mfma_f32_32x32x16_bf16(kf[3],qr[1],C1,0,0,0),   P0[14],P0[15],P1[0],P1[1],   pw1[2]=PKW(P0,12),pw1[3]=PKW(P0,14), pw1); \
    VRD(2); SBAR(); GAPA(C0=__builtin_amdgcn_mfma_f32_32x32x16_bf16(kf[4],qr[2],C0,0,0,0),   P1[2],P1[3],P1[4],P1[5],     pw2[0]=PKW(P1,0), pw2[1]=PKW(P1,2), pw2); \
    VRD(6); SBAR(); GAPA(C1=__builtin_amdgcn_mfma_f32_32x32x16_bf16(kf[5],qr[2],C1,0,0,0),   P1[6],P1[7],P1[8],P1[9],     pw2[2]=PKW(P1,4), pw2[3]=PKW(P1,6), pw2); \
    VRD(3); SBAR(); GAPA(C0=__builtin_amdgcn_mfma_f32_32x32x16_bf16(kf[6],qr[3],C0,0,0,0),   P1[10],P1[11],P1[12],P1[13], pw3[0]=PKW(P1,8), pw3[1]=PKW(P1,10), pw3); \
    VRD(7); SBAR(); GAPA(C1=__builtin_amdgcn_mfma_f32_32x32x16_bf16(kf[7],qr[3],C1,0,0,0),   P1[14],P1[15],0.f,0.f,       pw3[2]=PKW(P1,12),pw3[3]=PKW(P1,14), pw3); \
    l_reg+=sacc; \
    if(GK){DMA_K((t)+3,sl_cur);} if(GV){DMA_V((t)+1,sl_next);} \
    CMASK(C0,C1,t); \
    { float a=MX3(C0[0],C0[1],C1[0]),b=MX3(C0[2],C0[3],C1[1]); a=MX3(a,C1[2],C1[3]); \
      _Pragma("unroll") for(int r=4;r<16;r+=4){a=MX3(a,C0[r],C0[r+1]);b=MX3(b,C0[r+2],C0[r+3]);a=MX3(a,C1[r],C1[r+1]);b=MX3(b,C1[r+2],C1[r+3]);} \
      float rm=__builtin_fmaxf(a,b); { auto rr=__builtin_amdgcn_permlane32_swap(__float_as_uint(rm),__float_as_uint(rm),false,false); rm=__builtin_fmaxf(__uint_as_float(rr[0]),__uint_as_float(rr[1])); } \
      resc=false; \
      if(__builtin_expect(__any(rm>(float)THRL),0)){ const float dl=__builtin_fmaxf(rm,0.f); mhat+=dl; \
        _Pragma("unroll") for(int r=0;r<16;++r){C0[r]-=dl;C1[r]-=dl;} \
        _Pragma("unroll") for(int r=0;r<16;++r)negm[r]=-mhat; asm volatile("":"+v"(negm)); \
        const float f=__builtin_amdgcn_exp2f(-dl); l_reg*=f; if(hi==0)wsf[r32]=f; resc=true; } } \
    SBAR(); \
    GAPB(o[0]=__builtin_amdgcn_mfma_f32_32x32x16_bf16(PAF(0),VFR(0),o[0],0,0,0), C0,0); \
    GAPB(o[1]=__builtin_amdgcn_mfma_f32_32x32x16_bf16(PAF(0),VFR(4),o[1],0,0,0), C0,4); \
    KRD(GL,0); GAPB(o[0]=__builtin_amdgcn_mfma_f32_32x32x16_bf16(PAF(1),VFR(1),o[0],0,0,0), C0,8); \
    KRD(GL,1); GAPB(o[1]=__builtin_amdgcn_mfma_f32_32x32x16_bf16(PAF(1),VFR(5),o[1],0,0,0), C0,12); \
    KRD(GL,2); GAPB(o[0]=__builtin_amdgcn_mfma_f32_32x32x16_bf16(PAF(2),VFR(2),o[0],0,0,0), C1,0); \
    KRD(GL,3); GAPB(o[1]=__builtin_amdgcn_mfma_f32_32x32x16_bf16(PAF(2),VFR(6),o[1],0,0,0), C1,4); \
    GAPB(o[0]=__builtin_amdgcn_mfma_f32_32x32x16_bf16(PAF(3),VFR(3),o[0],0,0,0), C1,8); \
    GAPB(o[1]=__builtin_amdgcn_mfma_f32_32x32x16_bf16(PAF(3),VFR(7),o[1],0,0,0), C1,12); \
    }while(0)
  int t=1;
  #undef CMASK
  #define CMASK(P0,P1,t) do{}while(0)
  for(;t+5<NT;t+=2){
    STEP(pB0,pB1,pA0,pA1,t,true,true,true);     WAIT_BAR(2); RESC(); ROT();
    STEP(pA0,pA1,pB0,pB1,t+1,true,true,true);   WAIT_BAR(2); RESC(); ROT();
  }
  #undef CMASK
  #define CMASK(P0,P1,t) do{int jb_=(t)-(NT-4); if(jb_>=0)cmask(P0,P1,jb_,qrel,hi);}while(0)
  #define ENDW(tt) do{ if((tt)+3<NT){WAIT_BAR(2);} else if((tt)+2<NT){WAIT_BAR(1);} else {WAIT_BAR(0);} }while(0)
  for(;t+1<NT;t+=2){
    STEP(pB0,pB1,pA0,pA1,t,(t+3<NT),(t+1<NT),(t+1<NT));       ENDW(t);   RESC(); ROT();
    STEP(pA0,pA1,pB0,pB1,t+1,(t+4<NT),(t+2<NT),(t+2<NT));     ENDW(t+1); RESC(); ROT();
  }
  STEP(pB0,pB1,pA0,pA1,NT-1,false,false,false); RESC();
  { float sacc=pB0[0]+pB0[1]; _Pragma("unroll") for(int r=2;r<16;++r)sacc+=pB0[r]; _Pragma("unroll") for(int r=0;r<16;++r)sacc+=pB1[r]; l_reg+=sacc;
    pw0=(u32x4){PKW(pB0,0),PKW(pB0,2),PKW(pB0,4),PKW(pB0,6)};pw1=(u32x4){PKW(pB0,8),PKW(pB0,10),PKW(pB0,12),PKW(pB0,14)};pw2=(u32x4){PKW(pB1,0),PKW(pB1,2),PKW(pB1,4),PKW(pB1,6)};pw3=(u32x4){PKW(pB1,8),PKW(pB1,10),PKW(pB1,12),PKW(pB1,14)};
    SBAR(); pv(o,vb0+sl_cur,PAF(0),PAF(1),PAF(2),PAF(3)); }
  #undef PKW
  #undef PAF
  #undef VFR
  #undef PIN
  #undef MX3
  #undef GAPA
  #undef GAPB
  #undef EX
  #undef VRD
  #undef KRD
  #undef STEP
  #undef ENDW
  {auto rr=__builtin_amdgcn_permlane32_swap(__float_as_uint(l_reg),__float_as_uint(l_reg),false,false);l_reg=__uint_as_float(rr[0])+__uint_as_float(rr[1]);}
  if(hi==0)wsf[32+r32]=l_reg;asm volatile("s_waitcnt lgkmcnt(0)":::"memory");
  float rli[16];
  #pragma unroll
  for(int r=0;r<16;++r)rli[r]=__builtin_amdgcn_rcpf(wsf[32+crow(r,hi)]);
  bf16*Ow=O+(rowbase+q0+wid*QBLK)*PO;
  { bf16*stg=(bf16*)(shm+LDS_OST)+wid*2048;
    #pragma unroll
    for(int r=0;r<16;++r){const int orow=crow(r,hi);
      #pragma unroll
      for(int d0=0;d0<2;++d0)stg[orow*64+d0*32+r32]=__float2bfloat16(o[d0][r]*rli[r]);}
    asm volatile("s_waitcnt lgkmcnt(0)":::"memory");
    #pragma unroll
    for(int i=0;i<4;++i){const int row=i*8+(lane>>3),ch=lane&7; const u32x4 v=*(const u32x4*)(stg+row*64+ch*8); ATTN_STORE16(Ow+(long)row*PO+ch*8,v);} }
  asm volatile("s_waitcnt lgkmcnt(0)\n\ts_barrier":::"memory");
  #undef DMA_K
  #undef DMA_V
  #undef CMASK
  #undef START
  #undef RESC
  #undef ROT
}
constexpr int ATTN_LDS_BYTES=LDS_BYTES;
struct AttnTensors { const bf16* Q; const bf16* K; const bf16* V; bf16* O; };
struct AttnUnit { int bh; int qb; };
struct StaticOrder {
  int vcu;
  __device__ __forceinline__ explicit StaticOrder(int grid,int block):vcu((block%8)*(grid/8)+block/8){}
  __device__ __forceinline__ bool next(int i,AttnUnit&u)const{ if(i>=4)return false; const int s=vcu&7; u.bh=vcu>>3; u.qb=(i==0)?s:(i==1)?15-s:(i==2)?16+s:31-s; return true; }
  __device__ __forceinline__ void a_ready(const AttnUnit&)const{}
  __device__ __forceinline__ void done(const AttnUnit&)const{}
};
template<class Sched,int THRL=8> __device__ __forceinline__ void attn_phase(char*lds,const AttnTensors&T,const Sched&S){
  AttnUnit u;
  for(int i=0;S.next(i,u);++i){ S.a_ready(u); {const int vh=u.bh%NHEAD,hh=vh>>2,mm=(vh>>1)&1,vv=vh&1; attn_unit<THRL>(u.bh/NHEAD,u.qb,T.Q+hh*128+mm*64,T.K+hh*128+mm*64,T.V+hh*128+vv*64,T.O+hh*256+mm*128+vv*64,lds);} S.done(u); }
}
#undef SBAR
#undef WAIT_BAR
}
constexpr int NWAVES = 8, NTHR = 512;
#ifndef DEPTH_
#define DEPTH_ 4
#endif
constexpr int BATCH = 2, SEQ = 8192, DM_ = 1024, DEPTH = DEPTH_, MROWS = BATCH * SEQ;
constexpr int NPROJ = 3328;
constexpr int C_Z = 0, C_X = 512, C_B = 1024, C_C = 1280, C_Q = 1536, C_K = 2048, C_V = 2560, C_DT = 3072;
constexpr int DINP = 3080, DFF = 2816, NGU = 5632, NMOD = 6144;
constexpr float LN_EPS = 1e-5f, ALPHA = 1.681792830507429f;
constexpr size_t MiB = 1u << 20;
constexpr size_t WS_MOD = 1 * MiB, WS_DEC = 1 * MiB + 256 * 1024, WS_ROPE = 2 * MiB;
constexpr size_t WS_WIN = 4 * MiB, WS_WOUT = 30 * MiB, WS_WGU = 38 * MiB, WS_WDN = 82 * MiB;
constexpr size_t WS_PROJ = 104 * MiB;
constexpr size_t WS_H = 208 * MiB;
constexpr size_t WS_OATT = 240 * MiB, WS_YCAT = 272 * MiB;
constexpr size_t WS_YSSD = 304 * MiB, WS_END = 320 * MiB;
constexpr size_t WIN_L = (size_t)NPROJ * 1024, WOUT_L = (size_t)1024 * 1024, WGU_L = (size_t)NGU * 1024, WDN_L = (size_t)1024 * DFF;
constexpr int RING_BYTES = 131072;
constexpr int LDS_BYTES = 155648;
#define GAS __attribute__((address_space(1)))
#define LAS __attribute__((address_space(3)))
typedef unsigned short bf16;
typedef unsigned v4u __attribute__((ext_vector_type(4)));
typedef unsigned v2u __attribute__((ext_vector_type(2)));
typedef float f32x4 __attribute__((ext_vector_type(4)));
typedef short bf16x8 __attribute__((ext_vector_type(8)));
#define LDS_WAIT() asm volatile("s_waitcnt lgkmcnt(0)" ::: "memory")
__device__ __forceinline__ unsigned f2bf(float f) { unsigned u = __builtin_bit_cast(unsigned, f); return (u + 0x7fffu + ((u >> 16) & 1u)) >> 16; }
__device__ __forceinline__ unsigned pk2(float lo, float hi) { return f2bf(lo) | (f2bf(hi) << 16); }
__device__ __forceinline__ float bflo(unsigned w) { return __builtin_bit_cast(float, w << 16); }
__device__ __forceinline__ float bfhi(unsigned w) { return __builtin_bit_cast(float, w & 0xffff0000u); }
__device__ __forceinline__ float bf1(bf16 h) { return __builtin_bit_cast(float, (unsigned)h << 16); }
__device__ __forceinline__ float wave_sum(float v) {
#pragma unroll
    for (int o = 1; o < 64; o <<= 1) v += __shfl_xor(v, o);
    return v;
}
__device__ __forceinline__ float silu_f(float x) { return x / (1.f + __expf(-x)); }
__device__ __forceinline__ float softplus_f(float x) { return x > 20.f ? x : log1pf(__expf(x)); }

struct Args { const float* in[20]; float* out; unsigned char* ws; };

template <int MAP> __device__ __forceinline__ int colmap(int n) {
    if (MAP == 0) return n;
    if (MAP == 1) {
        if (n < C_Q) return n;
        if (n < C_V) { const int i = n - C_Q, blk = i >> 6, pos = i & 63; return 1544 + blk * 64 + (pos >> 1) + 32 * (pos & 1); }
        if (n < C_DT) return 2568 + (n - C_V);
        if (n < C_DT + 8) return 1536 + (n - C_DT);
        return -1;
    }
    return (n >> 1) + DFF * (n & 1);
}
template <int MAP> __device__ __forceinline__ void transpose_item(const float* W, int K, int Nsrc, int Ndst, bf16* WT, LAS float* scr, int item, int lane) {
    const int nblk = Ndst / 32, kb = item / nblk, nb = item % nblk, k0 = 64 * kb, n0 = 32 * nb;
    const int sc = colmap<MAP>(n0 + (lane & 31));
#pragma unroll 8
    for (int i = 0; i < 32; ++i) { const int kk = 2 * i + (lane >> 5); scr[kk * 33 + (lane & 31)] = sc >= 0 ? W[(size_t)(k0 + kk) * Nsrc + sc] : 0.f; }
    LDS_WAIT(); asm volatile("" ::: "memory");
    const int c = lane & 7;
#pragma unroll
    for (int j = 0; j < 4; ++j) { const int n = (lane >> 3) + 8 * j; const LAS float* s = scr + (8 * c) * 33 + n;
        v4u o; o.x = pk2(s[0 * 33], s[1 * 33]); o.y = pk2(s[2 * 33], s[3 * 33]); o.z = pk2(s[4 * 33], s[5 * 33]); o.w = pk2(s[6 * 33], s[7 * 33]);
        *(v4u*)(WT + (size_t)(n0 + n) * K + k0 + 8 * c) = o; }
    LDS_WAIT(); asm volatile("" ::: "memory");
}
__device__ __forceinline__ void p0_weights(const Args& a, LAS unsigned char* lds, int gw, int NGW, int wave, int lane) {
    LAS float* scr = (LAS float*)(lds + wave * 16384);
    constexpr int I_IN = (1024 / 64) * (NPROJ / 32), I_OUT = (1024 / 64) * (1024 / 32), I_GU = (1024 / 64) * (NGU / 32), I_DN = (DFF / 64) * (1024 / 32);
    constexpr int PER_L = I_IN + I_OUT + I_GU + I_DN;
    unsigned char* ws = a.ws;
    for (int it = gw; it < DEPTH * PER_L; it += NGW) {
        const int l = it / PER_L; int r = it % PER_L;
        if (r < I_IN) { transpose_item<1>(a.in[4] + (size_t)l * 1024 * DINP, 1024, DINP, NPROJ, (bf16*)(ws + WS_WIN) + l * WIN_L, scr, r, lane); continue; } r -= I_IN;
        if (r < I_OUT) { transpose_item<0>(a.in[13] + (size_t)l * 1024 * 1024, 1024, 1024, 1024, (bf16*)(ws + WS_WOUT) + l * WOUT_L, scr, r, lane); continue; } r -= I_OUT;
        if (r < I_GU) { transpose_item<2>(a.in[16] + (size_t)l * 1024 * NGU, 1024, NGU, NGU, (bf16*)(ws + WS_WGU) + l * WGU_L, scr, r, lane); continue; } r -= I_GU;
        transpose_item<0>(a.in[17] + (size_t)l * DFF * 1024, DFF, 1024, 1024, (bf16*)(ws + WS_WDN) + l * WDN_L, scr, r, lane);
    }
}
__device__ __forceinline__ void p0_mod(const Args& a, LAS unsigned char* lds, int vcu, int G, int tid) {
    LAS float* sc = (LAS float*)lds;
    LAS float* red = sc + 2048;
    const float* c = a.in[1];
    for (int i = tid; i < 2048; i += NTHR) sc[i] = silu_f(c[i]);
    __syncthreads();
    float* mod = (float*)(a.ws + WS_MOD);
    const int col = tid & 63, ks = tid >> 6;
    for (int it = vcu; it < DEPTH * (NMOD / 64); it += G) {
        const int l = it / (NMOD / 64), n0 = (it % (NMOD / 64)) * 64;
        const float* W = a.in[2] + (size_t)l * 1024 * NMOD + n0 + col;
        float a0 = 0.f, a1 = 0.f;
#pragma unroll 8
        for (int k = ks * 128; k < ks * 128 + 128; ++k) { const float w = W[(size_t)k * NMOD]; a0 += sc[k] * w; a1 += sc[1024 + k] * w; }
        red[(ks * 64 + col) * 2] = a0; red[(ks * 64 + col) * 2 + 1] = a1;
        __syncthreads();
        if (tid < 128) { const int cc = tid & 63, b = tid >> 6; float s = 0.f;
#pragma unroll
            for (int q = 0; q < 8; ++q) s += red[(q * 64 + cc) * 2 + b];
            mod[((size_t)l * 2 + b) * NMOD + n0 + cc] = s + a.in[3][(size_t)l * NMOD + n0 + cc]; }
        __syncthreads();
    }
}
__device__ __forceinline__ void p0_rope(const Args& a, int gtid, int NT) {
    float* rope = (float*)(a.ws + WS_ROPE);
    for (int i = gtid; i < SEQ * 32; i += NT) {
        const int t = i >> 5, j = i & 31;
        double inv = 1.0; for (int q = 0; q < j; ++q) inv *= 0.7498942093324559;
        const float invf = (float)inv; const float ang = (float)t * invf;
        double r = (double)ang; const double kq = __builtin_rint(r * 0.15915494309189535); r = r - kq * 6.283185307179586;
        const double r2 = r * r;
        double s = 1.0, cc = 1.0;
#pragma unroll
        for (int n = 12; n >= 1; --n) { s = 1.0 - s * r2 / (double)((2 * n) * (2 * n + 1)); cc = 1.0 - cc * r2 / (double)((2 * n - 1) * (2 * n)); }
        rope[2 * i] = (float)cc; rope[2 * i + 1] = (float)(s * r);
    }
}
__device__ __forceinline__ void p0_h0(const Args& a, int gw, int NGW, int lane) {
    const float* mod = (const float*)(a.ws + WS_MOD);
    bf16* H = (bf16*)(a.ws + WS_H);
    for (int m = gw; m < MROWS; m += NGW) {
        const int b = m >> 13; const float* mb = mod + (size_t)b * NMOD;
        const f32x4* xr = (const f32x4*)(a.in[0] + (size_t)m * 1024) + lane;
        unsigned long long* o8 = (unsigned long long*)(H + (size_t)m * 1024) + lane;
#pragma unroll
        for (int j = 0; j < 4; ++j) { const f32x4 v = xr[64 * j]; const f32x4 sh = *((const f32x4*)mb + lane + 64 * j), scl = *((const f32x4*)(mb + 1024) + lane + 64 * j);
            const f32x4 h = v * (scl + 1.f) + sh;
            o8[64 * j] = (unsigned long long)pk2(h.x, h.y) | ((unsigned long long)pk2(h.z, h.w) << 32); }
    }
}
__device__ __forceinline__ void ln_pass(const float* xin, const float* y, float* xout, bf16* H, const float* gate  , const float* lg, const float* lb,
                                        const float* hshift, const float* hscale, int gw, int NGW, int lane) {
    for (int m = gw; m < MROWS; m += NGW) {
        const int b = m >> 13;
        const f32x4* xr = (const f32x4*)(xin + (size_t)m * 1024) + lane; const f32x4* yr = (const f32x4*)(y + (size_t)m * 1024) + lane;
        const f32x4* gr = (const f32x4*)(gate + (size_t)b * NMOD) + lane;
        f32x4 v[4]; float s = 0.f;
#pragma unroll
        for (int j = 0; j < 4; ++j) { v[j] = xr[64 * j] * ALPHA + (gr[64 * j] + 1.f) * yr[64 * j]; s += (v[j].x + v[j].y) + (v[j].z + v[j].w); }
        const float mean = wave_sum(s) * (1.f / 1024.f); float s2 = 0.f;
#pragma unroll
        for (int j = 0; j < 4; ++j) { v[j] = v[j] - mean; s2 += (v[j].x * v[j].x + v[j].y * v[j].y) + (v[j].z * v[j].z + v[j].w * v[j].w); }
        const float rstd = 1.f / sqrtf(wave_sum(s2) * (1.f / 1024.f) + LN_EPS);
        f32x4* xo = (f32x4*)(xout + (size_t)m * 1024) + lane;
        unsigned long long* o8 = (unsigned long long*)(H + (size_t)m * 1024) + lane;
#pragma unroll
        for (int j = 0; j < 4; ++j) { const f32x4 xn = v[j] * rstd * *((const f32x4*)lg + lane + 64 * j) + *((const f32x4*)lb + lane + 64 * j);
            xo[64 * j] = xn;
            if (hshift) { const f32x4 h = xn * (*((const f32x4*)(hscale + (size_t)b * NMOD) + lane + 64 * j) + 1.f) + *((const f32x4*)(hshift + (size_t)b * NMOD) + lane + 64 * j);
                o8[64 * j] = (unsigned long long)pk2(h.x, h.y) | ((unsigned long long)pk2(h.z, h.w) << 32); } }
    }
}
__device__ __forceinline__ void finalize_pass(const Args& a, int l, int gw, int NGW, int lane) {
    const bf16* YS = (const bf16*)(a.ws + WS_YSSD); const bf16* OA = (const bf16*)(a.ws + WS_OATT); bf16* YC = (bf16*)(a.ws + WS_YCAT);
    const float* lq = a.in[11] + (size_t)l * 256;
    const float e1 = wave_sum(lq[lane] * lq[64 + lane]), e2 = wave_sum(lq[128 + lane] * lq[192 + lane]);
    const float lam_init = 0.8f - 0.6f * expf(-0.3f * (float)l);
    const float lam = expf(e1) - expf(e2) + lam_init;
    float wn[8], wa[8];
#pragma unroll
    for (int j = 0; j < 8; ++j) { wn[j] = a.in[10][(size_t)l * 512 + lane * 8 + j]; wa[j] = a.in[12][(size_t)l * 128 + (lane & 15) * 8 + j] * (1.f - lam_init); }
    for (int m = gw; m < MROWS; m += NGW) {
        const v4u ys = *((const v4u*)(YS + (size_t)m * 512) + lane);
        const int hh = lane >> 4, d0 = (lane & 15) * 8;
        const v4u o1 = *(const v4u*)(OA + (size_t)m * 1024 + hh * 256 + d0), o2 = *(const v4u*)(OA + (size_t)m * 1024 + hh * 256 + 128 + d0);
        float y[8] = {bflo(ys.x), bfhi(ys.x), bflo(ys.y), bfhi(ys.y), bflo(ys.z), bfhi(ys.z), bflo(ys.w), bfhi(ys.w)};
        float p[8] = {bflo(o1.x), bfhi(o1.x), bflo(o1.y), bfhi(o1.y), bflo(o1.z), bfhi(o1.z), bflo(o1.w), bfhi(o1.w)};
        float q[8] = {bflo(o2.x), bfhi(o2.x), bflo(o2.y), bfhi(o2.y), bflo(o2.z), bfhi(o2.z), bflo(o2.w), bfhi(o2.w)};
        float sy = 0.f, so = 0.f;
#pragma unroll
        for (int j = 0; j < 8; ++j) { sy += y[j] * y[j]; p[j] = p[j] - lam * q[j]; so += p[j] * p[j]; }
#pragma unroll
        for (int o = 1; o < 32; o <<= 1) sy += __shfl_xor(sy, o);
#pragma unroll
        for (int o = 1; o < 16; o <<= 1) so += __shfl_xor(so, o);
        const float ry = 1.f / sqrtf(sy * (1.f / 256.f) + LN_EPS), ro = 1.f / sqrtf(so * (1.f / 128.f) + LN_EPS);
        v4u w1, w2;
        w1.x = pk2(y[0] * ry * wn[0], y[1] * ry * wn[1]); w1.y = pk2(y[2] * ry * wn[2], y[3] * ry * wn[3]); w1.z = pk2(y[4] * ry * wn[4], y[5] * ry * wn[5]); w1.w = pk2(y[6] * ry * wn[6], y[7] * ry * wn[7]);
        w2.x = pk2(p[0] * ro * wa[0], p[1] * ro * wa[1]); w2.y = pk2(p[2] * ro * wa[2], p[3] * ro * wa[3]); w2.z = pk2(p[4] * ro * wa[4], p[5] * ro * wa[5]); w2.w = pk2(p[6] * ro * wa[6], p[7] * ro * wa[7]);
        *((v4u*)(YC + (size_t)m * 1024) + lane) = w1;
        *(v4u*)(YC + (size_t)m * 1024 + 512 + hh * 128 + d0) = w2;
    }
}
constexpr int SP = 136, SPB = SP * 2;
constexpr int L_C = 0, L_B = 128 * SPB, L_M = 2 * 128 * SPB, L_XT = 3 * 128 * SPB, L_PV = L_XT + 64 * SPB, L_TAB = L_PV + 64 * SPB;
static_assert(L_TAB + 4096 <= LDS_BYTES, "ssd lds");
template <int NT> __device__ __forceinline__ void conv_tile(float (&v)[NT][8], const bf16* P, int col, size_t row, int t, const float* cw, const float* cb) {
    const int ch = col - C_X;
    float w[4][8], bias[8];
#pragma unroll
    for (int k = 0; k < 4; ++k) { const f32x4 a = *(const f32x4*)(cw + k * 1024 + ch), b = *(const f32x4*)(cw + k * 1024 + ch + 4);
        w[k][0] = a.x; w[k][1] = a.y; w[k][2] = a.z; w[k][3] = a.w; w[k][4] = b.x; w[k][5] = b.y; w[k][6] = b.z; w[k][7] = b.w; }
    { const f32x4 a = *(const f32x4*)(cb + ch), b = *(const f32x4*)(cb + ch + 4); bias[0] = a.x; bias[1] = a.y; bias[2] = a.z; bias[3] = a.w; bias[4] = b.x; bias[5] = b.y; bias[6] = b.z; bias[7] = b.w; }
    float u[NT + 3][8];
#pragma unroll
    for (int i = 0; i < NT + 3; ++i) {
        v4u r = (v4u){0u, 0u, 0u, 0u};
        if (t + i - 3 >= 0) r = *(const v4u*)(P + (row + i - 3) * NPROJ + col);
        u[i][0] = bflo(r.x); u[i][1] = bfhi(r.x); u[i][2] = bflo(r.y); u[i][3] = bfhi(r.y); u[i][4] = bflo(r.z); u[i][5] = bfhi(r.z); u[i][6] = bflo(r.w); u[i][7] = bfhi(r.w);
    }
#pragma unroll
    for (int i = 0; i < NT; ++i)
#pragma unroll
        for (int c = 0; c < 8; ++c) { const float s = bias[c] + w[0][c] * u[i][c] + w[1][c] * u[i + 1][c] + w[2][c] * u[i + 2][c] + w[3][c] * u[i + 3][c]; v[i][c] = silu_f(s); }
}
__device__ __forceinline__ void ssd_tables(const Args& a, int l, LAS unsigned char* lds, const bf16* P, size_t row0, int g, int tid) {
    LAS float* acs = (LAS float*)(lds + L_TAB); LAS float* dtv = acs + 512;
    const int e = tid >> 7, ll = tid & 127, h = g * 4 + e;
    const float dt = softplus_f(bf1(P[(row0 + ll) * NPROJ + C_DT + h]) + a.in[7][l * 8 + h]);
    const float av = -__expf(a.in[8][l * 8 + h]) * dt;
    dtv[tid] = dt; acs[tid] = av;
    __syncthreads();
    float s = 0.f;
    for (int k = 0; k <= ll; ++k) s += acs[e * 128 + k];
    __syncthreads();
    acs[tid] = s;
    __syncthreads();
}
__device__ __forceinline__ bf16x8 ldfrag(const LAS unsigned char* base, int row, int kel) { return *(const LAS bf16x8*)(base + row * SPB + kel * 2); }
__device__ __forceinline__ void ssd_states_unit(const Args& a, int l, LAS unsigned char* lds, int unit, int tid, int wave, int lane) {
    const int g = unit & 1, c = (unit >> 1) & 63, b = unit >> 7;
    const bf16* P = (const bf16*)(a.ws + WS_PROJ); const size_t row0 = (size_t)b * SEQ + c * 128; const int t0 = c * 128;
    const float* cw = a.in[5] + (size_t)l * 4 * 1024; const float* cb = a.in[6] + (size_t)l * 1024;
    ssd_tables(a, l, lds, P, row0, g, tid);
    LAS float* acs = (LAS float*)(lds + L_TAB); LAS float* dtv = acs + 512;
    if (tid < 4) ((float*)(a.ws + WS_DEC))[(b * 64 + c) * 8 + g * 4 + tid] = __expf(acs[tid * 128 + 127]);
    {
        const int cg8 = tid & 31, ts = tid >> 5, e = cg8 >> 3;
        float v[8][8]; conv_tile<8>(v, P, C_X + g * 256 + cg8 * 8, row0 + ts * 8, t0 + ts * 8, cw, cb);
        float wl[8]; const float alast = acs[e * 128 + 127];
#pragma unroll
        for (int i = 0; i < 8; ++i) wl[i] = dtv[e * 128 + ts * 8 + i] * __expf(alast - acs[e * 128 + ts * 8 + i]);
#pragma unroll
        for (int cc = 0; cc < 8; ++cc) { v4u o; o.x = pk2(v[0][cc] * wl[0], v[1][cc] * wl[1]); o.y = pk2(v[2][cc] * wl[2], v[3][cc] * wl[3]); o.z = pk2(v[4][cc] * wl[4], v[5][cc] * wl[5]); o.w = pk2(v[6][cc] * wl[6], v[7][cc] * wl[7]);
            *(LAS v4u*)(lds + L_B + (cg8 * 8 + cc) * SPB + ts * 16) = o; }
    }
    if (tid < 256) {
        const int cg8 = tid & 15, ts = tid >> 4;
        float v[8][8]; conv_tile<8>(v, P, C_B + g * 128 + cg8 * 8, row0 + ts * 8, t0 + ts * 8, cw, cb);
#pragma unroll
        for (int cc = 0; cc < 8; ++cc) { v4u o; o.x = pk2(v[0][cc], v[1][cc]); o.y = pk2(v[2][cc], v[3][cc]); o.z = pk2(v[4][cc], v[5][cc]); o.w = pk2(v[6][cc], v[7][cc]);
            *(LAS v4u*)(lds + L_C + (cg8 * 8 + cc) * SPB + ts * 16) = o; }
    }
    __syncthreads();
    {
        const int e = wave >> 1, nh = wave & 1, fr = lane & 15, fq = lane >> 4;
        f32x4 acc[4][4];
#pragma unroll
        for (int i = 0; i < 4; ++i)
#pragma unroll
            for (int j = 0; j < 4; ++j) acc[i][j] = (f32x4){0.f, 0.f, 0.f, 0.f};
#pragma unroll
        for (int ks = 0; ks < 4; ++ks) {
            bf16x8 af[4], bfr[4];
#pragma unroll
            for (int i = 0; i < 4; ++i) { af[i] = ldfrag(lds + L_B, e * 64 + i * 16 + fr, ks * 32 + fq * 8); bfr[i] = ldfrag(lds + L_C, nh * 64 + i * 16 + fr, ks * 32 + fq * 8); }
#pragma unroll
            for (int i = 0; i < 4; ++i)
#pragma unroll
                for (int j = 0; j < 4; ++j) acc[i][j] = __builtin_amdgcn_mfma_f32_16x16x32_bf16(af[i], bfr[j], acc[i][j], 0, 0, 0);
        }
        float* ST = (float*)(a.ws + WS_H) + ((size_t)((b * 64 + c) * 8 + g * 4 + e)) * 8192;
#pragma unroll
        for (int i = 0; i < 4; ++i)
#pragma unroll
            for (int j = 0; j < 4; ++j)
#pragma unroll
                for (int r = 0; r < 4; ++r) ST[(i * 16 + fq * 4 + r) * 128 + nh * 64 + j * 16 + fr] = acc[i][j][r];
    }
    __syncthreads();
}
__device__ __forceinline__ void ssd_scan(const Args& a, int gtid, int NT) {
    float* ST = (float*)(a.ws + WS_H); const float* DEC = (const float*)(a.ws + WS_DEC);
    for (int i = gtid; i < 2 * 8 * 8192; i += NT) {
        const int b = i >> 16, rem = i & 65535, h = rem >> 13;
        float* p = ST + (size_t)b * 64 * 65536 + rem; const float* d = DEC + b * 512 + h;
        float hs = 0.f;
#pragma unroll 8
        for (int c = 0; c < 64; ++c) { const float st = p[(size_t)c * 65536]; p[(size_t)c * 65536] = hs; hs = d[c * 8] * hs + st; }
    }
}
__device__ __forceinline__ void ssd_out_unit(const Args& a, int l, LAS unsigned char* lds, int unit, int tid, int wave, int lane) {
    const int g = unit & 1, c = (unit >> 1) & 63, b = unit >> 7;
    const bf16* P = (const bf16*)(a.ws + WS_PROJ); const size_t row0 = (size_t)b * SEQ + c * 128; const int t0 = c * 128;
    const float* cw = a.in[5] + (size_t)l * 4 * 1024; const float* cb = a.in[6] + (size_t)l * 1024;
    bf16* YS = (bf16*)(a.ws + WS_YSSD);
    ssd_tables(a, l, lds, P, row0, g, tid);
    LAS float* acs = (LAS float*)(lds + L_TAB); LAS float* dtv = acs + 512;
    {
        const int cg8 = tid & 31, ts = tid >> 5, isC = cg8 >> 4, cgi = cg8 & 15;
        float v[8][8]; conv_tile<8>(v, P, (isC ? C_C : C_B) + g * 128 + cgi * 8, row0 + ts * 8, t0 + ts * 8, cw, cb);
#pragma unroll
        for (int i = 0; i < 8; ++i) { v4u o; o.x = pk2(v[i][0], v[i][1]); o.y = pk2(v[i][2], v[i][3]); o.z = pk2(v[i][4], v[i][5]); o.w = pk2(v[i][6], v[i][7]);
            *(LAS v4u*)(lds + (isC ? L_C : L_B) + (ts * 8 + i) * SPB + cgi * 16) = o; }
    }
    __syncthreads();
    const int fr = lane & 15, fq = lane >> 4;
    f32x4 cbm[8];
#pragma unroll
    for (int j = 0; j < 8; ++j) cbm[j] = (f32x4){0.f, 0.f, 0.f, 0.f};
#pragma unroll
    for (int ks = 0; ks < 4; ++ks) {
        const bf16x8 af = ldfrag(lds + L_C, wave * 16 + fr, ks * 32 + fq * 8);
#pragma unroll
        for (int j = 0; j < 8; ++j) { const bf16x8 bfr = ldfrag(lds + L_B, j * 16 + fr, ks * 32 + fq * 8); cbm[j] = __builtin_amdgcn_mfma_f32_16x16x32_bf16(af, bfr, cbm[j], 0, 0, 0); }
    }
    for (int e = 0; e < 4; ++e) {
        const int h = g * 4 + e;
        __syncthreads();
        {
            const int cg8 = tid & 7, ts = tid >> 3;
            float v[2][8]; conv_tile<2>(v, P, C_X + g * 256 + e * 64 + cg8 * 8, row0 + ts * 2, t0 + ts * 2, cw, cb);
#pragma unroll
            for (int cc = 0; cc < 8; ++cc) *(LAS unsigned*)(lds + L_XT + (cg8 * 8 + cc) * SPB + ts * 4) = pk2(v[0][cc], v[1][cc]);
        }
        {
            const float* ST = (const float*)(a.ws + WS_H) + ((size_t)((b * 64 + c) * 8 + h)) * 8192;
            const int p = tid >> 3, n0 = (tid & 7) * 16;
            const f32x4 s0 = *(const f32x4*)(ST + p * 128 + n0), s1 = *(const f32x4*)(ST + p * 128 + n0 + 4), s2 = *(const f32x4*)(ST + p * 128 + n0 + 8), s3 = *(const f32x4*)(ST + p * 128 + n0 + 12);
            v4u o0, o1; o0.x = pk2(s0.x, s0.y); o0.y = pk2(s0.z, s0.w); o0.z = pk2(s1.x, s1.y); o0.w = pk2(s1.z, s1.w); o1.x = pk2(s2.x, s2.y); o1.y = pk2(s2.z, s2.w); o1.z = pk2(s3.x, s3.y); o1.w = pk2(s3.z, s3.w);
            *(LAS v4u*)(lds + L_PV + p * SPB + n0 * 2) = o0; *(LAS v4u*)(lds + L_PV + p * SPB + n0 * 2 + 16) = o1;
        }
        {
            const float dsk = a.in[9][l * 8 + h];
#pragma unroll
            for (int r = 0; r < 4; ++r) { const int ll = wave * 16 + fq * 4 + r; const float al = acs[e * 128 + ll];
#pragma unroll
                for (int j = 0; j < 8; ++j) { const int s = j * 16 + fr;
                    float mv = 0.f;
                    if (s <= ll) { mv = cbm[j][r] * __expf(al - acs[e * 128 + s]) * dtv[e * 128 + s]; if (s == ll) mv += dsk; }
                    *(LAS bf16*)(lds + L_M + ll * SPB + s * 2) = (bf16)f2bf(mv); } }
        }
        __syncthreads();
        f32x4 y1[4], y2[4];
#pragma unroll
        for (int j = 0; j < 4; ++j) { y1[j] = (f32x4){0.f, 0.f, 0.f, 0.f}; y2[j] = y1[j]; }
#pragma unroll
        for (int ks = 0; ks < 4; ++ks) {
            const bf16x8 am = ldfrag(lds + L_M, wave * 16 + fr, ks * 32 + fq * 8), ac = ldfrag(lds + L_C, wave * 16 + fr, ks * 32 + fq * 8);
#pragma unroll
            for (int j = 0; j < 4; ++j) { const bf16x8 bx = ldfrag(lds + L_XT, j * 16 + fr, ks * 32 + fq * 8), bp = ldfrag(lds + L_PV, j * 16 + fr, ks * 32 + fq * 8);
                y1[j] = __builtin_amdgcn_mfma_f32_16x16x32_bf16(am, bx, y1[j], 0, 0, 0); y2[j] = __builtin_amdgcn_mfma_f32_16x16x32_bf16(ac, bp, y2[j], 0, 0, 0); }
        }
#pragma unroll
        for (int r = 0; r < 4; ++r) { const int ll = wave * 16 + fq * 4 + r; const float ea = __expf(acs[e * 128 + ll]);
#pragma unroll
            for (int j = 0; j < 4; ++j) { const int ch = g * 256 + e * 64 + j * 16 + fr;
                const float z = bf1(P[(row0 + ll) * NPROJ + C_Z + ch]);
                const float y = (y1[j][r] + ea * y2[j][r]) * silu_f(z);
                YS[(row0 + ll) * 512 + ch] = (bf16)f2bf(y); } }
    }
    __syncthreads();
}
struct AttnSched {
    int G, bx, vcu;
    __device__ __forceinline__ bool next(int i, attn_body::AttnUnit& u) const {
        if (G == 256) { if (i >= 4) return false; const int s = vcu & 7; u.bh = vcu >> 3; u.qb = (i == 0) ? s : (i == 1) ? 15 - s : (i == 2) ? 16 + s : 31 - s; return true; }
        const int idx = bx + i * G; if (idx >= 1024) return false; u.bh = idx & 31; u.qb = 31 - (idx >> 5); return true;
    }
    __device__ __forceinline__ void a_ready(const attn_body::AttnUnit&) const {}
    __device__ __forceinline__ void done(const attn_body::AttnUnit&) const {}
};

#define PH_BEGIN { int tid = opaque_tid(); const int lane = tid & 63, wave = __builtin_amdgcn_readfirstlane(tid >> 6); \
    int bx = blockIdx.x, G = gridDim.x; unsigned long long wsi_ = (unsigned long long)a.ws; asm volatile("" : "+s"(bx), "+s"(G), "+s"(wsi_)); unsigned char* ws = (unsigned char*)(__attribute__((address_space(1))) unsigned char*)wsi_; \
    const int vcu = (G % 8 == 0) ? (bx % 8) * (G / 8) + bx / 8 : bx; const int NGW = G * NWAVES, NTT = G * NTHR, gw = vcu * NWAVES + wave, gtid = bx * NTHR + tid; \
    (void)lane; (void)wave; (void)vcu; (void)NGW; (void)NTT; (void)gw; (void)gtid; (void)ws;
#define PH_END }
__global__ void __launch_bounds__(NTHR, 2) fwd_kernel(Args a) {
    extern __shared__ __attribute__((aligned(16))) unsigned char lds_raw[];
    cg::grid_group grid = cg::this_grid();
    LAS unsigned char* lds = (LAS unsigned char*)lds_raw;

    PH_BEGIN
        p0_mod(a, lds, bx, G, tid);
        p0_rope(a, gtid, NTT);
        p0_weights(a, lds, gw, NGW, wave, lane);
    PH_END
    grid.sync();
    PH_BEGIN p0_h0(a, gw, NGW, lane); PH_END
    grid.sync();

#pragma unroll 1
    for (int l = 0; l < DEPTH; ++l) {
#ifndef NO_G1
        PH_BEGIN
            pg8::Gemm g{(const bf16*)(ws + WS_H), (const bf16*)(ws + WS_WIN) + l * WIN_L, MROWS, NPROJ, 1024}; pg8::StaticOrder S; S.init(MROWS, NPROJ, G, bx);
            pg8::EpiInProj E{(bf16*)(ws + WS_PROJ), NPROJ, (const float*)(ws + WS_ROPE), attn_body::C2};
            pg8::gemm_phase<pg8::EpiInProj, pg8::StaticOrder, true, true>(lds, g, S, E);
        PH_END
#endif
        grid.sync();
#ifndef NO_S1
        PH_BEGIN for (int u = bx; u < 256; u += G) ssd_states_unit(a, l, lds, u, tid, wave, lane); PH_END
#endif
        grid.sync();
        PH_BEGIN ssd_scan(a, gtid, NTT); PH_END
        grid.sync();
#ifndef NO_S3
        PH_BEGIN for (int u = bx; u < 256; u += G) ssd_out_unit(a, l, lds, u, tid, wave, lane); PH_END
#endif
#ifndef NO_ATT
        PH_BEGIN
            const attn_body::AttnTensors AT{(const attn_body::bf16*)(ws + WS_PROJ) + C_Q, (const attn_body::bf16*)(ws + WS_PROJ) + C_K, (const attn_body::bf16*)(ws + WS_PROJ) + C_V, (attn_body::bf16*)(ws + WS_OATT)};
            const AttnSched S{G, bx, vcu};
            attn_body::attn_phase<AttnSched>((char*)lds_raw, AT, S);
        PH_END
#endif
        grid.sync();
        PH_BEGIN finalize_pass(a, l, gw, NGW, lane); PH_END
        grid.sync();
#ifndef NO_G2
        PH_BEGIN
            pg8::Gemm g{(const bf16*)(ws + WS_YCAT), (const bf16*)(ws + WS_WOUT) + l * WOUT_L, MROWS, 1024, 1024}; pg8::StaticOrder S; S.init(MROWS, 1024, G, bx);
            pg8::EpiF32 E{(float*)(ws + WS_PROJ), 1024};
            pg8::gemm_phase<pg8::EpiF32, pg8::StaticOrder, true, true>(lds, g, S, E);
        PH_END
#endif
        grid.sync();
        PH_BEGIN
            const float* modl = (const float*)(ws + WS_MOD) + (size_t)l * 2 * NMOD;
            ln_pass(l == 0 ? a.in[0] : a.out, (const float*)(ws + WS_PROJ), a.out, (bf16*)(ws + WS_H), modl + 2 * 1024, a.in[14] + l * 1024, a.in[15] + l * 1024, modl + 3 * 1024, modl + 4 * 1024, gw, NGW, lane);
        PH_END
        grid.sync();
#ifndef NO_G3
        PH_BEGIN
            pg8::Gemm g{(const bf16*)(ws + WS_H), (const bf16*)(ws + WS_WGU) + l * WGU_L, MROWS, NGU, 1024}; pg8::StaticOrder S; S.init(MROWS, NGU, G, bx);
            pg8::EpiSwiGLU E{(bf16*)(ws + WS_PROJ), DFF};
            pg8::gemm_phase<pg8::EpiSwiGLU, pg8::StaticOrder, true, true>(lds, g, S, E);
        PH_END
#endif
        grid.sync();
#ifndef NO_G4
        PH_BEGIN
            pg8::Gemm g{(const bf16*)(ws + WS_PROJ), (const bf16*)(ws + WS_WDN) + l * WDN_L, MROWS, 1024, DFF}; pg8::StaticOrder S; S.init(MROWS, 1024, G, bx);
            pg8::EpiF32 E{(float*)(ws + WS_OATT), 1024};
            pg8::gemm_phase<pg8::EpiF32, pg8::StaticOrder, true, true>(lds, g, S, E);
        PH_END
#endif
        grid.sync();
        PH_BEGIN
            const float* modl = (const float*)(ws + WS_MOD) + (size_t)l * 2 * NMOD;
            const bool last = (l == DEPTH - 1); const float* modn = modl + 2 * NMOD;
            ln_pass(a.out, (const float*)(ws + WS_OATT), a.out, (bf16*)(ws + WS_H), modl + 5 * 1024, a.in[18] + l * 1024, a.in[19] + l * 1024, last ? nullptr : modn, last ? nullptr : modn + 1024, gw, NGW, lane);
        PH_END
        grid.sync();
    }
}

extern "C" void kernel_launch(void* const* d_in, const int* in_sizes, int n_in, void* d_out, int out_size, void* d_ws, size_t ws_size, hipStream_t stream) {
    static int grid = 0;
    if (grid == 0) {
        if (n_in != 20 || in_sizes[0] != MROWS * 1024 || out_size != MROWS * 1024 || ws_size < WS_END) { fprintf(stderr, "kernel_launch: unexpected shapes / workspace (n_in %d, ws %zu)\n", n_in, ws_size); grid = -1; return; }
        int dev = 0, cus = 0, per_cu = 0;
        if (hipGetDevice(&dev) != hipSuccess || hipDeviceGetAttribute(&cus, hipDeviceAttributeMultiprocessorCount, dev) != hipSuccess) { grid = -1; return; }
        if (hipFuncSetAttribute((const void*)fwd_kernel, hipFuncAttributeMaxDynamicSharedMemorySize, LDS_BYTES) != hipSuccess) { fprintf(stderr, "kernel_launch: hipFuncSetAttribute failed\n"); grid = -1; return; }
        if (hipOccupancyMaxActiveBlocksPerMultiprocessor(&per_cu, (const void*)fwd_kernel, NTHR, LDS_BYTES) != hipSuccess || per_cu < 1) { fprintf(stderr, "kernel_launch: occupancy query says %d\n", per_cu); per_cu = 1; }
        (void)hipGetLastError();
        grid = cus;
    }
    if (grid < 0) return;
    Args a{};
    for (int i = 0; i < 20; ++i) a.in[i] = (const float*)d_in[i];
    a.out = (float*)d_out; a.ws = (unsigned char*)d_ws;
    void* args[] = {&a};
    hipError_t e = hipLaunchCooperativeKernel((const void*)fwd_kernel, dim3(grid), dim3(NTHR), args, LDS_BYTES, stream);
    if (e != hipSuccess) fprintf(stderr, "cooperative launch failed: %s (grid %d)\n", hipGetErrorString(e), grid);
}
```

```cpp
#include <hip/hip_runtime.h>
#include <hip/hip_cooperative_groups.h>
#include <cstdio>
#include <cstdint>
namespace cg = cooperative_groups;
__device__ __forceinline__ int opaque_tid() { int t = threadIdx.x; asm volatile("" : "+v"(t)); return t; }
namespace pg8 {
#define PG8_LAS __attribute__((address_space(3)))
typedef unsigned short bf16_t;
typedef short bf16x8 __attribute__((ext_vector_type(8)));
typedef float f32x4 __attribute__((ext_vector_type(4)));
typedef unsigned u32x4 __attribute__((ext_vector_type(4)));
constexpr int BM = 256, BK = 64, HALF = 128, HTB = HALF * BK * 2  , STAGE_BYTES = 8 * HTB, NXCD = 8, WGM = 8;

__host__ __device__ __forceinline__ int lds_byte(int r, int c) { const int st = (r >> 4) * 2 + (c >> 5), rr = r & 15, cc = c & 31, ob = rr * 64 + cc * 2; return st * 1024 + (ob ^ (((ob >> 9) & 1) << 5)); }
__host__ __device__ __forceinline__ void stage_rc(int b, int& R, int& C) { const int st = b / 1024, sb = b % 1024, swz = sb ^ (((sb >> 9) & 1) << 5); R = (st >> 1) * 16 + swz / 64; C = (st & 1) * 32 + (swz % 64) / 2; }
__host__ __device__ __forceinline__ int perm32(int rho) { const int n = rho >> 4, i = rho & 15; return 8 * (i >> 2) + 4 * n + (i & 3); }

struct Unit { int pm, pn; };
struct Gemm { const bf16_t* A; const bf16_t* Bt; int M, N, K; };

struct StaticOrder {
    int nM, nN, nwg, G, c;
    __host__ __device__ void init(int M, int N, int G_, int c_) { nM = M / BM; nN = N / BM; nwg = nM * nN; G = G_; c = c_; }
    __host__ __device__ bool next(int i, Unit& u) const {
        const long L = (long)i * G + c; if (L >= nwg) return false;
        int wgid = (int)L; { const int q = nwg / NXCD, r = nwg % NXCD, xcd = wgid % NXCD, off = wgid / NXCD; wgid = (xcd < r ? xcd * (q + 1) : r * (q + 1) + (xcd - r) * q) + off; }
        const int nig = WGM * nN, gid = wgid / nig, fm = gid * WGM, gsz = (nM - fm) < WGM ? (nM - fm) : WGM;
        u.pm = fm + ((wgid % nig) % gsz); u.pn = (wgid % nig) / gsz; return true;
    }
    __device__ __forceinline__ void a_ready(const Unit&) const {}
    __device__ __forceinline__ void done(const Unit&) const {}
};

__device__ __forceinline__ unsigned cvt_pk_bf16(float lo, float hi) { unsigned r; asm volatile("v_cvt_pk_bf16_f32 %0, %1, %2" : "=v"(r) : "v"(lo), "v"(hi)); return r; }
typedef float f32x2 __attribute__((ext_vector_type(2)));
__device__ __forceinline__ f32x2 gelu_pk(f32x2 v) {
    const f32x2 av = __builtin_elementwise_abs(v), d = av * 0.2316418882f + 1.0f;
    f32x2 t; t.x = __builtin_amdgcn_rcpf(d.x); t.y = __builtin_amdgcn_rcpf(d.y);
    f32x2 q = t * 0.5307027145f + (-0.7265760135f); q = q * t + 0.7107068705f; q = q * t + (-0.142248368f); q = q * t + 0.127414796f; q = q * t;
    const f32x2 s = (v * v) * (-0.72134752044f);
    f32x2 e; e.x = __builtin_amdgcn_exp2f(s.x); e.y = __builtin_amdgcn_exp2f(s.y);
    const f32x2 m = v * (q * e), r = v - m;
    f32x2 o; o.x = v.x < 0.f ? m.x : r.x; o.y = v.y < 0.f ? m.y : r.y; return o;
}

template <int ACT  > struct EpiBf16 {
    static constexpr bool PERM = true, AFTER_DRAIN = false; static_assert(ACT == 0 || ACT == 1, "EpiBf16: ACT is 0 (none) or 1 (gelu_pk)");
    bf16_t* O; int ldc; const float* bias; int split_cols; size_t split_stride; float scale0;
    __device__ __forceinline__ void operator()(const f32x4 (&acc)[2][2][4][2], const Unit& u, int wr, int wc, int fr, int fq) const {
        const int row0 = u.pm * BM + wr * 64 + fr; int colt = u.pn * BM; bf16_t* base = O;
        float sc = 1.f; if (split_cols) { const int t = colt / split_cols; base += (size_t)t * split_stride; colt -= t * split_cols; if (t == 0) sc = scale0; }
        const int col0 = colt + wc * 32 + 8 * fq, bcol0 = u.pn * BM + wc * 32 + 8 * fq;
        f32x4 bv[2][2];
#pragma unroll
        for (int bj = 0; bj < 2; ++bj)
#pragma unroll
            for (int n = 0; n < 2; ++n) bv[bj][n] = bias ? *(const f32x4*)(bias + bcol0 + bj * HALF + 4 * n) : (f32x4){0.f, 0.f, 0.f, 0.f};
#pragma unroll
        for (int ai = 0; ai < 2; ++ai)
#pragma unroll
            for (int m = 0; m < 4; ++m) { bf16_t* rowp = base + (size_t)(row0 + ai * HALF + m * 16) * ldc + col0;
#pragma unroll
                for (int bj = 0; bj < 2; ++bj) { f32x4 v0 = acc[ai][bj][m][0] + bv[bj][0], v1 = acc[ai][bj][m][1] + bv[bj][1];
                    if (ACT == 1) { f32x2 a = gelu_pk((f32x2){v0[0], v0[1]}), b = gelu_pk((f32x2){v0[2], v0[3]}), c = gelu_pk((f32x2){v1[0], v1[1]}), d = gelu_pk((f32x2){v1[2], v1[3]});
                        v0 = (f32x4){a.x, a.y, b.x, b.y}; v1 = (f32x4){c.x, c.y, d.x, d.y}; }
                    v0 = v0 * sc; v1 = v1 * sc; u32x4 w; w.x = cvt_pk_bf16(v0[0], v0[1]); w.y = cvt_pk_bf16(v0[2], v0[3]); w.z = cvt_pk_bf16(v1[0], v1[1]); w.w = cvt_pk_bf16(v1[2], v1[3]);
                    *(u32x4*)(rowp + bj * HALF) = w; } }
    }
};
typedef float f32x2e __attribute__((ext_vector_type(2)));
typedef unsigned u32x2e __attribute__((ext_vector_type(2)));
struct EpiInProj {
    static constexpr bool PERM = true, AFTER_DRAIN = false;
    bf16_t* O; int ldc; const float* rope; float qscale;
    __device__ __forceinline__ void operator()(const f32x4 (&acc)[2][2][4][2], const Unit& u, int wr, int wc, int fr, int fq) const {
        const int row0 = u.pm * BM + wr * 64 + fr; const int colt = u.pn * BM;
        const int col0 = colt + wc * 32 + 8 * fq;
        const bool is_q = (u.pn == 6 || u.pn == 7), is_k = (u.pn == 8 || u.pn == 9);
        const float sc = is_q ? qscale : 1.f;
        const int j0 = 16 * (wc & 1) + 4 * fq;
#pragma unroll
        for (int ai = 0; ai < 2; ++ai)
#pragma unroll
            for (int m = 0; m < 4; ++m) { const int row = row0 + ai * HALF + m * 16; bf16_t* rowp = O + (size_t)row * ldc + col0;
                f32x4 r0 = (f32x4){1.f, 0.f, 1.f, 0.f}, r1 = r0;
                if (is_q || is_k) { const float* rp = rope + ((size_t)(row & 8191) * 32 + j0) * 2; r0 = *(const f32x4*)rp; r1 = *(const f32x4*)(rp + 4); }
#pragma unroll
                for (int bj = 0; bj < 2; ++bj) { f32x4 v0 = acc[ai][bj][m][0], v1 = acc[ai][bj][m][1];
                    if (is_q || is_k) {
                        f32x4 o0, o1;
                        o0[0] = v0[0] * r0[0] - v0[1] * r0[1]; o0[1] = v0[1] * r0[0] + v0[0] * r0[1];
                        o0[2] = v0[2] * r0[2] - v0[3] * r0[3]; o0[3] = v0[3] * r0[2] + v0[2] * r0[3];
                        o1[0] = v1[0] * r1[0] - v1[1] * r1[1]; o1[1] = v1[1] * r1[0] + v1[0] * r1[1];
                        o1[2] = v1[2] * r1[2] - v1[3] * r1[3]; o1[3] = v1[3] * r1[2] + v1[2] * r1[3];
                        v0 = o0 * sc; v1 = o1 * sc; }
                    u32x4 w; w.x = cvt_pk_bf16(v0[0], v0[1]); w.y = cvt_pk_bf16(v0[2], v0[3]); w.z = cvt_pk_bf16(v1[0], v1[1]); w.w = cvt_pk_bf16(v1[2], v1[3]);
                    *(u32x4*)(rowp + bj * HALF) = w; } }
    }
};
struct EpiSwiGLU {
    static constexpr bool PERM = true, AFTER_DRAIN = false;
    bf16_t* O; int ldo;
    __device__ __forceinline__ void operator()(const f32x4 (&acc)[2][2][4][2], const Unit& u, int wr, int wc, int fr, int fq) const {
        const int row0 = u.pm * BM + wr * 64 + fr; const int i0 = u.pn * (BM / 2) + wc * 16 + 4 * fq;
#pragma unroll
        for (int ai = 0; ai < 2; ++ai)
#pragma unroll
            for (int m = 0; m < 4; ++m) { bf16_t* rowp = O + (size_t)(row0 + ai * HALF + m * 16) * ldo + i0;
#pragma unroll
                for (int bj = 0; bj < 2; ++bj) { const f32x4 v0 = acc[ai][bj][m][0], v1 = acc[ai][bj][m][1];
                    float g[4] = {v0[0], v0[2], v1[0], v1[2]}, uu[4] = {v0[1], v0[3], v1[1], v1[3]}, o[4];
#pragma unroll
                    for (int e = 0; e < 4; ++e) o[e] = g[e] * __builtin_amdgcn_rcpf(1.f + __builtin_amdgcn_exp2f(-1.4426950408889634f * g[e])) * uu[e];
                    u32x2e w; w.x = cvt_pk_bf16(o[0], o[1]); w.y = cvt_pk_bf16(o[2], o[3]);
                    *(u32x2e*)(rowp + bj * (HALF / 2)) = w; } }
    }
};
struct EpiF32 {
    static constexpr bool PERM = false, AFTER_DRAIN = false;
    float* O; int ldc;
    __device__ __forceinline__ void operator()(const f32x4 (&acc)[2][2][4][2], const Unit& u, int wr, int wc, int fr, int fq) const {
        const int row0 = u.pm * BM + wr * 64 + fr; const int col0 = u.pn * BM + wc * 32 + 4 * fq;
#pragma unroll
        for (int ai = 0; ai < 2; ++ai)
#pragma unroll
            for (int m = 0; m < 4; ++m) { float* rowp = O + (size_t)(row0 + ai * HALF + m * 16) * ldc + col0;
#pragma unroll
                for (int bj = 0; bj < 2; ++bj)
#pragma unroll
                    for (int n = 0; n < 2; ++n) *(f32x4*)(rowp + bj * HALF + n * 16) = acc[ai][bj][m][n]; }
    }
};
template <class Epi, class Sched, bool ALIGN_EPI = false, bool SP2 = false>
__device__ __forceinline__ void gemm_phase(PG8_LAS unsigned char* lds, const Gemm g, const Sched& S, const Epi& E) {
    const int tid = opaque_tid(), wid = __builtin_amdgcn_readfirstlane(tid >> 6), lane = tid & 63, wr = wid >> 2, wc = wid & 3, fr = lane & 15, fq = lane >> 4;
    const int K = g.K, nt = K / BK;
    unsigned voffA[2], voffB[2];
#pragma unroll
    for (int i = 0; i < 2; ++i) { int R, C; stage_rc(tid * 16 + i * 8192, R, C); const int Rb = Epi::PERM ? ((R & ~31) + perm32(R & 31)) : R;
        voffA[i] = (unsigned)(R * K + C) * 2u; voffB[i] = (unsigned)(Rb * K + C) * 2u; }
    const size_t kstep = (size_t)(BK * 2);
    const size_t hstep = (size_t)HALF * K * 2;
    const size_t tstep = 2 * hstep;
    const unsigned ldsw = (unsigned)wid * 1024u;
    const int aoff = lds_byte(wr * 64 + fr, fq * 8), boff = lds_byte(wc * 32 + fr, fq * 8);
#define PG8_SA(b, h) (((b) * 2 + (h)) * HTB)
#define PG8_SB(b, h) ((4 + (b) * 2 + (h)) * HTB)
#define PG8_STAGE(bufoff, gbase, voff) do { _Pragma("unroll") for (int _i = 0; _i < 2; ++_i) \
        __builtin_amdgcn_global_load_lds((const unsigned*)((const char*)(gbase) + (voff)[_i]), (PG8_LAS unsigned*)(lds + (bufoff) + ldsw + _i * 8192), 16, 0, 0); } while (0)
#define PG8_LDA(dst, b, h) do { _Pragma("unroll") for (int m = 0; m < 4; ++m) _Pragma("unroll") for (int k = 0; k < 2; ++k) dst[m][k] = *(const PG8_LAS bf16x8*)(lds + PG8_SA(b, h) + aoff + m * 2048 + k * 1024); } while (0)
#define PG8_LDB(dst, b, h) do { _Pragma("unroll") for (int n = 0; n < 2; ++n) _Pragma("unroll") for (int k = 0; k < 2; ++k) dst[n][k] = *(const PG8_LAS bf16x8*)(lds + PG8_SB(b, h) + boff + n * 2048 + k * 1024); } while (0)
#define PG8_MMA(ai, bj, At, Bt) do { __builtin_amdgcn_s_setprio(1); _Pragma("unroll") for (int m = 0; m < 4; ++m) _Pragma("unroll") for (int n = 0; n < 2; ++n) _Pragma("unroll") for (int k = 0; k < 2; ++k) \
        acc[ai][bj][m][n] = __builtin_amdgcn_mfma_f32_16x16x32_bf16(Bt[n][k], At[m][k], acc[ai][bj][m][n], 0, 0, 0); __builtin_amdgcn_s_setprio(0); } while (0)
#define PG8_WAIT_V(n) asm volatile("s_waitcnt vmcnt(" #n ")" ::: "memory")
#define PG8_WAIT_L(n) asm volatile("s_waitcnt lgkmcnt(" #n ")" ::: "memory")
#define PG8_BAR __builtin_amdgcn_s_barrier()
#define PG8_SCHED __builtin_amdgcn_sched_barrier(0)
    Unit cur, nxt; int ui = 0;
    if (!S.next(0, cur)) return;
    f32x4 acc[2][2][4][2];
#pragma unroll
    for (int a = 0; a < 2; ++a)
#pragma unroll
        for (int b = 0; b < 2; ++b)
#pragma unroll
            for (int m = 0; m < 4; ++m)
#pragma unroll
                for (int n = 0; n < 2; ++n) acc[a][b][m][n] = (f32x4){0.f, 0.f, 0.f, 0.f};
    bf16x8 At[4][2], B0[2][2], B1[2][2];
    const char* cA = (const char*)g.A + (size_t)cur.pm * tstep; const char* cB = (const char*)g.Bt + (size_t)cur.pn * tstep;
    S.a_ready(cur);
    if constexpr (SP2) {
        PG8_STAGE(PG8_SB(0, 0), cB, voffB); PG8_STAGE(PG8_SB(0, 1), cB + hstep, voffB); PG8_STAGE(PG8_SA(0, 0), cA, voffA); PG8_STAGE(PG8_SA(0, 1), cA + hstep, voffA);
        if (wr == 1) PG8_BAR;
        PG8_WAIT_V(2); PG8_BAR;
        PG8_STAGE(PG8_SB(1, 0), cB + kstep, voffB); PG8_STAGE(PG8_SA(1, 0), cA + kstep, voffA); PG8_STAGE(PG8_SB(1, 1), cB + hstep + kstep, voffB);
        PG8_WAIT_V(6); PG8_BAR;
    } else {
        PG8_STAGE(PG8_SB(0, 0), cB, voffB); PG8_STAGE(PG8_SA(0, 0), cA, voffA); PG8_STAGE(PG8_SB(0, 1), cB + hstep, voffB); PG8_STAGE(PG8_SA(0, 1), cA + hstep, voffA);
        if (wr == 1) PG8_BAR;
        PG8_WAIT_V(4); PG8_BAR;
        PG8_STAGE(PG8_SB(1, 0), cB + kstep, voffB); PG8_STAGE(PG8_SA(1, 0), cA + kstep, voffA); PG8_STAGE(PG8_SB(1, 1), cB + hstep + kstep, voffB);
        PG8_WAIT_V(6); PG8_BAR;
    }
    for (;;) {
        const bool has_next = S.next(ui + 1, nxt);
        const char* nA = has_next ? (const char*)g.A + (size_t)nxt.pm * tstep : cA; const char* nB = has_next ? (const char*)g.Bt + (size_t)nxt.pn * tstep : cB;
        for (int t = 0; t < nt; t += 2) {
            const bool last = (t == nt - 2);
            const char* a1 = cA + (size_t)(t + 1) * kstep;
            const char* a2 = last ? nA : cA + (size_t)(t + 2) * kstep; const char* b2 = last ? nB : cB + (size_t)(t + 2) * kstep;
            const char* a3 = a2 + kstep; const char* b3 = b2 + kstep;
            if (last && has_next) S.a_ready(nxt);
            if constexpr (SP2) {
            PG8_LDB(B0, 0, 0); PG8_LDB(B1, 0, 1); PG8_SCHED; PG8_LDA(At, 0, 0); PG8_STAGE(PG8_SA(1, 1), a1 + hstep, voffA);
            PG8_WAIT_V(8); PG8_WAIT_L(0); PG8_BAR; PG8_MMA(0, 0, At, B0); PG8_MMA(0, 1, At, B1); PG8_BAR; PG8_SCHED;
            PG8_LDA(At, 0, 1); PG8_STAGE(PG8_SB(0, 0), b2, voffB); PG8_STAGE(PG8_SB(0, 1), b2 + hstep, voffB); PG8_STAGE(PG8_SA(0, 0), a2, voffA);
            PG8_WAIT_V(8); PG8_WAIT_L(0); PG8_BAR; PG8_MMA(1, 0, At, B0); PG8_MMA(1, 1, At, B1); PG8_BAR; PG8_SCHED;
            PG8_LDB(B0, 1, 0); PG8_LDB(B1, 1, 1); PG8_SCHED; PG8_LDA(At, 1, 0); PG8_STAGE(PG8_SA(0, 1), a2 + hstep, voffA);
            PG8_WAIT_V(8); PG8_WAIT_L(0); PG8_BAR; PG8_MMA(0, 0, At, B0); PG8_MMA(0, 1, At, B1); PG8_BAR; PG8_SCHED;
            PG8_LDA(At, 1, 1); PG8_STAGE(PG8_SB(1, 0), b3, voffB); PG8_STAGE(PG8_SB(1, 1), b3 + hstep, voffB); PG8_STAGE(PG8_SA(1, 0), a3, voffA);
            PG8_WAIT_V(8); PG8_WAIT_L(0); PG8_BAR; PG8_MMA(1, 0, At, B0); PG8_MMA(1, 1, At, B1); PG8_BAR; PG8_SCHED;
            } else {
            PG8_LDB(B0, 0, 0); PG8_SCHED; PG8_LDA(At, 0, 0); PG8_STAGE(PG8_SA(1, 1), a1 + hstep, voffA);
            PG8_WAIT_L(8); PG8_BAR; PG8_WAIT_L(0); PG8_MMA(0, 0, At, B0); PG8_BAR; PG8_SCHED;
            PG8_LDB(B1, 0, 1); PG8_STAGE(PG8_SB(0, 0), b2, voffB);
            PG8_BAR; PG8_WAIT_L(0); PG8_MMA(0, 1, At, B1); PG8_BAR;
            PG8_LDA(At, 0, 1); PG8_STAGE(PG8_SA(0, 0), a2, voffA);
            PG8_BAR; PG8_WAIT_L(0); PG8_MMA(1, 0, At, B0); PG8_BAR; PG8_SCHED;
            PG8_STAGE(PG8_SB(0, 1), b2 + hstep, voffB);
            PG8_WAIT_V(6); PG8_BAR; PG8_MMA(1, 1, At, B1); PG8_BAR;
            PG8_LDB(B0, 1, 0); PG8_SCHED; PG8_LDA(At, 1, 0); PG8_STAGE(PG8_SA(0, 1), a2 + hstep, voffA);
            PG8_WAIT_L(8); PG8_BAR; PG8_WAIT_L(0); PG8_MMA(0, 0, At, B0); PG8_BAR; PG8_SCHED;
            PG8_LDB(B1, 1, 1); PG8_STAGE(PG8_SB(1, 0), b3, voffB);
            PG8_BAR; PG8_WAIT_L(0); PG8_MMA(0, 1, At, B1); PG8_BAR;
            PG8_LDA(At, 1, 1); PG8_STAGE(PG8_SA(1, 0), a3, voffA);
            PG8_BAR; PG8_WAIT_L(0); PG8_MMA(1, 0, At, B0); PG8_BAR; PG8_SCHED;
            PG8_STAGE(PG8_SB(1, 1), b3 + hstep, voffB);
            PG8_WAIT_V(6); PG8_BAR; PG8_MMA(1, 1, At, B1); PG8_BAR;
            }
        }
        if constexpr (ALIGN_EPI) { if (wr == 0) PG8_BAR; }
        if constexpr (!Epi::AFTER_DRAIN) { E(acc, cur, wr, wc, fr, fq); S.done(cur); }
        if (!has_next) break;
#pragma unroll
        for (int a = 0; a < 2; ++a)
#pragma unroll
            for (int b = 0; b < 2; ++b)
#pragma unroll
                for (int m = 0; m < 4; ++m)
#pragma unroll
                    for (int n = 0; n < 2; ++n) acc[a][b][m][n] = (f32x4){0.f, 0.f, 0.f, 0.f};
        cur = nxt; cA = nA; cB = nB; ++ui;
        if constexpr (ALIGN_EPI) { if (wr == 1) PG8_BAR; }
    }
    PG8_WAIT_V(0);
    if constexpr (!ALIGN_EPI) { if (wr == 0) PG8_BAR; }
    PG8_BAR;
    if constexpr (Epi::AFTER_DRAIN) { E.fused(acc, cur, wr, wc, fr, fq, lds, wid, lane); S.done(cur); }
#undef PG8_SA
#undef PG8_SB
#undef PG8_STAGE
#undef PG8_LDA
#undef PG8_LDB
#undef PG8_MMA
#undef PG8_WAIT_V
#undef PG8_WAIT_L
#undef PG8_BAR
#undef PG8_SCHED
}
}
#define PG8_SP2 true
#include <hip/hip_bf16.h>
#include <cmath>
namespace attn_body {
using bf16=__hip_bfloat16;
using bf16x8=__attribute__((ext_vector_type(8)))short;
using s16x4=__attribute__((ext_vector_type(4)))short;
using f32x16=__attribute__((ext_vector_type(16)))float;
using u32x4=__attribute__((ext_vector_type(4)))unsigned;
constexpr int BATCH=2,NHEAD=16,SEQ=8192,D=64,DM=3328,PO=1024;
constexpr int NW=8,QBLK=32,QB=QBLK*NW,KVBLK=64,NQB=SEQ/QB;
constexpr int ATTN_PITCH=DM, ATTN_UNIT_ROWS=QB;
__device__ __forceinline__ int crow(int r,int hi){return (r&3)+8*(r>>2)+4*hi;}
#define SBAR() __builtin_amdgcn_sched_barrier(0)
__device__ __forceinline__ void cmask(f32x16&p0,f32x16&p1,int jb,int qrel,int hi){
  const float NEG=-INFINITY; int kb=64*jb+4*hi;
  #pragma unroll
  for(int r=0;r<16;++r){int kv=kb+(r&3)+8*(r>>2); if(kv>qrel)p0[r]=NEG; if(kv+32>qrel)p1[r]=NEG;}
}

constexpr int NSLOT=3, SLOTB=8192;
constexpr int LDS_K=0, LDS_V=NSLOT*SLOTB, LDS_WS=2*NSLOT*SLOTB, LDS_OST=LDS_WS+NW*64*4, LDS_BYTES=LDS_OST+NW*4096;
constexpr float C2=0.125f*1.4426950408889634f;
__device__ __forceinline__ void glds16(const void*gsrc,unsigned lds_dst){unsigned keep;
  asm volatile("s_mov_b32 %0, m0\n\ts_mov_b32 m0, %2\n\ts_nop 0\n\tglobal_load_lds_dwordx4 %1, off\n\ts_mov_b32 m0, %0":"=&s"(keep):"v"(gsrc),"s"(lds_dst):"memory");}
__device__ __forceinline__ float max3f(float a,float b,float c){float r;asm("v_max3_f32 %0, %1, %2, %3":"=v"(r):"v"(a),"v"(b),"v"(c));return r;}
__device__ __forceinline__ float max2f(float a,float b){float r;asm("v_max_f32_e32 %0, %1, %2":"=v"(r):"v"(a),"v"(b));return r;}
__device__ __forceinline__ float fadd_s(float a,float b){float r;asm("v_add_f32_e32 %0, %1, %2":"=v"(r):"v"(a),"v"(b));return r;}
__device__ __forceinline__ float fsub_s(float a,float b){float r;asm("v_sub_f32_e32 %0, %1, %2":"=v"(r):"v"(a),"v"(b));return r;}
typedef float f32x2_t __attribute__((ext_vector_type(2))); typedef __bf16 bf16x2_t __attribute__((ext_vector_type(2)));
__device__ __forceinline__ unsigned cvtpk_s(float lo,float hi){f32x2_t v={lo,hi};bf16x2_t b=__builtin_convertvector(v,bf16x2_t);return __builtin_bit_cast(unsigned,b);}
#define WAIT_BAR(N) asm volatile("s_waitcnt vmcnt(" #N ") lgkmcnt(0)\n\ts_barrier":::"memory")

__device__ __forceinline__ void qkt(f32x16&p0,f32x16&p1,const char*Kslot,const bf16x8*qr,const f32x16&negm,int r32,int hi){
  const char*kb=Kslot+hi*1024+r32*16;
  #pragma unroll
  for(int d0=0;d0<4;++d0){
    const bf16x8 b0=*reinterpret_cast<const bf16x8*>(kb+d0*2048);
    const bf16x8 b1=*reinterpret_cast<const bf16x8*>(kb+d0*2048+512);
    if(d0==0){p0=__builtin_amdgcn_mfma_f32_32x32x16_bf16(b0,qr[0],negm,0,0,0);p1=__builtin_amdgcn_mfma_f32_32x32x16_bf16(b1,qr[0],negm,0,0,0);}
    else{p0=__builtin_amdgcn_mfma_f32_32x32x16_bf16(b0,qr[d0],p0,0,0,0);p1=__builtin_amdgcn_mfma_f32_32x32x16_bf16(b1,qr[d0],p1,0,0,0);}}
}
typedef __attribute__((address_space(3))) const char* lds_cptr;
typedef short v4i16_t __attribute__((ext_vector_type(4)));
__device__ __forceinline__ void kload8(bf16x8*kf,lds_cptr kp){
  kf[0]=*(const __attribute__((address_space(3))) bf16x8*)(kp);      kf[1]=*(const __attribute__((address_space(3))) bf16x8*)(kp+512);
  kf[2]=*(const __attribute__((address_space(3))) bf16x8*)(kp+2048); kf[3]=*(const __attribute__((address_space(3))) bf16x8*)(kp+2560);
  kf[4]=*(const __attribute__((address_space(3))) bf16x8*)(kp+4096); kf[5]=*(const __attribute__((address_space(3))) bf16x8*)(kp+4608);
  kf[6]=*(const __attribute__((address_space(3))) bf16x8*)(kp+6144); kf[7]=*(const __attribute__((address_space(3))) bf16x8*)(kp+6656);
}
__device__ __forceinline__ void kload2(bf16x8*kf,lds_cptr kp,int j){ kf[2*j]=*(const __attribute__((address_space(3))) bf16x8*)(kp+j*2048); kf[2*j+1]=*(const __attribute__((address_space(3))) bf16x8*)(kp+j*2048+512); }
__device__ __forceinline__ s16x4 vtr(lds_cptr p){ return __builtin_bit_cast(s16x4,__builtin_amdgcn_ds_read_tr16_b64_v4i16((__attribute__((address_space(3))) v4i16_t*)p)); }
__device__ __forceinline__ float rowmax(const f32x16&p0,const f32x16&p1){
  float a=max3f(p0[0],p0[1],p1[0]),b=max3f(p0[2],p0[3],p1[1]);a=max3f(a,p1[2],p1[3]);
  #pragma unroll
  for(int r=4;r<16;r+=4){a=max3f(a,p0[r],p0[r+1]);b=max3f(b,p0[r+2],p0[r+3]);a=max3f(a,p1[r],p1[r+1]);b=max3f(b,p1[r+2],p1[r+3]);}
  const float m=max2f(a,b);
  auto rr=__builtin_amdgcn_permlane32_swap(__float_as_uint(m),__float_as_uint(m),false,false);
  return max2f(__uint_as_float(rr[0]),__uint_as_float(rr[1]));
}
__device__ __forceinline__ void pv(f32x16*o,int vb,bf16x8 pa0,bf16x8 pa1,bf16x8 pa2,bf16x8 pa3){
  #pragma unroll
  for(int d0=0;d0<2;++d0){s16x4 lo[4],hi[4];
    #pragma unroll
    for(int ks=0;ks<4;++ks){
      asm volatile("ds_read_b64_tr_b16 %0,%1 offset:%c2":"=&v"(lo[ks]):"v"(vb),"i"(d0*4096+ks*1024):"memory");
      asm volatile("ds_read_b64_tr_b16 %0,%1 offset:%c2":"=&v"(hi[ks]):"v"(vb),"i"(d0*4096+ks*1024+512):"memory");}
    asm volatile("s_waitcnt lgkmcnt(0)":::"memory");SBAR();
    #define PK(k) (bf16x8){lo[k][0],lo[k][1],lo[k][2],lo[k][3],hi[k][0],hi[k][1],hi[k][2],hi[k][3]}
    o[d0]=__builtin_amdgcn_mfma_f32_32x32x16_bf16(pa0,PK(0),o[d0],0,0,0);
    o[d0]=__builtin_amdgcn_mfma_f32_32x32x16_bf16(pa1,PK(1),o[d0],0,0,0);
    o[d0]=__builtin_amdgcn_mfma_f32_32x32x16_bf16(pa2,PK(2),o[d0],0,0,0);
    o[d0]=__builtin_amdgcn_mfma_f32_32x32x16_bf16(pa3,PK(3),o[d0],0,0,0);
    #undef PK
  }
}

#ifndef ATTN_STORE16
#define ATTN_STORE16(p,v) (*(u32x4*)(p)=(v))
#endif
template<int THRL> __device__ __forceinline__ void attn_unit(int b,int qb,const bf16*Q,const bf16*__restrict__ K,const bf16*__restrict__ V,bf16*O,char*shm){
  const int tid=opaque_tid(),lane=tid&63,r32=lane&31,hi=lane>>5; const int wid=__builtin_amdgcn_readfirstlane(tid>>6);
  const long rowbase=(long)b*SEQ; const int q0=qb*QB;
  const bf16*Qw=Q+(rowbase+q0+wid*QBLK)*DM;
  const bf16*Kh=K+rowbase*DM,*Vh=V+rowbase*DM;
  const unsigned lds0=(unsigned)(uintptr_t)shm;
  float*wsf=(float*)(shm+LDS_WS)+wid*64;
  const bf16*ksrc=Kh+(long)lane*DM+wid*8;
  const bf16*vsrc=Vh+(long)(16*(wid&3)+(lane>>2))*DM+(wid>>2)*32+(lane&3)*8;
  const unsigned kdst=lds0+LDS_K+wid*1024, vdst=lds0+LDS_V+wid*1024;
  #define DMA_K(t,slot) glds16(ksrc+(long)(t)*KVBLK*DM,(unsigned)__builtin_amdgcn_readfirstlane(kdst+(slot)))
  #define DMA_V(t,slot) glds16(vsrc+(long)(t)*KVBLK*DM,(unsigned)__builtin_amdgcn_readfirstlane(vdst+(slot)))
  const int vb0=(int)(lds0+LDS_V)+((lane>>4)&1)*32+(lane&3)*8+(4*hi+((lane&15)>>2))*64;
  const char*Kbase=shm+LDS_K; bf16x8 kf[8];
  const lds_cptr shm3=(lds_cptr)shm; const lds_cptr kp0=shm3+LDS_K+hi*1024+r32*16; const lds_cptr vp0=shm3+LDS_V+((lane>>4)&1)*32+(lane&3)*8+(4*hi+((lane&15)>>2))*64;
  const int NT=(q0+QB)/KVBLK;
  DMA_K(0,0);DMA_V(0,0);DMA_K(1,SLOTB);
  bf16x8 qr[4];
  #pragma unroll
  for(int d0=0;d0<4;++d0)qr[d0]=*reinterpret_cast<const bf16x8*>(&Qw[(long)r32*DM+d0*16+hi*8]);
  float mhat=0.f,l_reg=0.f;f32x16 o[2];o[0]=f32x16{};o[1]=f32x16{};f32x16 negm=f32x16{};asm volatile("":"+v"(negm));
  const int qrel=wid*QBLK+r32;
  #define CMASK(P0,P1,t) do{int jb_=(t)-(NT-4); if(jb_>=0)cmask(P0,P1,jb_,qrel,hi);}while(0)
  bool resc=false;
  #define START(P0,P1) do{ const float rm=rowmax(P0,P1); resc=false; \
    { const float dl=rm; mhat=fadd_s(mhat,dl); \
      _Pragma("unroll") for(int r=0;r<16;++r){P0[r]=fsub_s(P0[r],dl);P1[r]=fsub_s(P1[r],dl);} \
      _Pragma("unroll") for(int r=0;r<16;++r)negm[r]=-mhat; asm volatile("":"+v"(negm)); } \
    _Pragma("unroll") for(int r=0;r<16;++r)P0[r]=__builtin_amdgcn_exp2f(P0[r]); }while(0)
  #define RESC() do{ if(resc){ asm volatile("s_waitcnt lgkmcnt(0)":::"memory"); \
      _Pragma("unroll") for(int d_=0;d_<2;++d_) _Pragma("unroll") for(int r=0;r<16;++r)o[d_][r]*=wsf[crow(r,hi)]; } }while(0)
  f32x16 pA0,pA1,pB0,pB1;
  int sl_prev=0,sl_cur=0,sl_next=SLOTB;
  #define ROT() do{sl_prev=sl_cur;sl_cur=sl_next;sl_next=(sl_next==(NSLOT-1)*SLOTB)?0:sl_next+SLOTB;}while(0)
  DMA_K(2,2*SLOTB);
  WAIT_BAR(3);
  qkt(pA0,pA1,Kbase,qr,negm,r32,hi);asm volatile("s_nop 15\n\ts_nop 7":"+v"(pA0),"+v"(pA1));CMASK(pA0,pA1,0);
  START(pA0,pA1);
  _Pragma("unroll") for(int r=0;r<16;++r)pA1[r]=__builtin_amdgcn_exp2f(pA1[r]);
  WAIT_BAR(0);
  DMA_K(3,0);DMA_V(1,SLOTB);
  ROT();
  kload8(kf,kp0+sl_cur);
  WAIT_BAR(2);
  s16x4 vlo[8],vhi[8]; u32x4 pw0,pw1,pw2,pw3;
  #define PKW(P,B) cvtpk_s(P[B],P[B+1])
  #define PAF(k) __builtin_bit_cast(bf16x8,pw##k)
  #define VFR(i) (bf16x8){vlo[i][0],vlo[i][1],vlo[i][2],vlo[i][3],vhi[i][0],vhi[i][1],vhi[i][2],vhi[i][3]}
  #define PIN(x) asm volatile("":"+v"(x))
  #define MX3(a,b,c) __builtin_fmaxf(__builtin_fmaxf((a),(b)),(c))
  #define GAPA(MF,A0,A1,A2,A3,W0,W1,PW) do{ MF; sacc+=A0; sacc+=A1; sacc+=A2; sacc+=A3; PIN(sacc); W0; W1; PIN(PW); SBAR(); }while(0)
  #define EX(v) __builtin_amdgcn_exp2f(v)
  #define GAPB(MF,X,B) do{ MF; X[B]=EX(X[B]); X[B+1]=EX(X[B+1]); X[B+2]=EX(X[B+2]); X[B+3]=EX(X[B+3]); PIN(X); SBAR(); }while(0)
  #define VRD(i) do{ vlo[i]=vtr(vp_+(((i)>>2)*4096+((i)&3)*1024)); vhi[i]=vtr(vp_+(((i)>>2)*4096+((i)&3)*1024+512)); }while(0)
  #define KRD(G,j) do{ if(G){ kload2(kf,kp0+sl_next,j); SBAR(); } }while(0)
  #define STEP(C0,C1,P0,P1,t,GK,GV,GL) do{ SBAR(); \
    const lds_cptr vp_=vp0+sl_prev; \
    VRD(0); SBAR(); float sacc=(P0[0]+P0[1]); \
    GAPA(C0=__builtin_amdgcn_mfma_f32_32x32x16_bf16(kf[0],qr[0],negm,0,0,0), P0[2],P0[3],P0[4],P0[5],     pw0[0]=PKW(P0,0), pw0[1]=PKW(P0,2), pw0); \
    VRD(4); SBAR(); GAPA(C1=__builtin_amdgcn_mfma_f32_32x32x16_bf16(kf[1],qr[0],negm,0,0,0), P0[6],P0[7],P0[8],P0[9],     pw0[2]=PKW(P0,4), pw0[3]=PKW(P0,6), pw0); \
    VRD(1); SBAR(); GAPA(C0=__builtin_amdgcn_mfma_f32_32x32x16_bf16(kf[2],qr[1],C0,0,0,0),   P0[10],P0[11],P0[12],P0[13], pw1[0]=PKW(P0,8), pw1[1]=PKW(P0,10), pw1); \
    VRD(5); SBAR(); GAPA(C1=__builtin_amdgcn_mfma_f32_32x32x16_bf16(kf[3],qr[1],C1,0,0,0),   P0[14],P0[15],P1[0],P1[1],   pw1[2]=PKW(P0,12),pw1[3]=PKW(P0,14), pw1); \
    VRD(2); SBAR(); GAPA(C0=__builtin_amdgcn_mfma_f32_32x32x16_bf16(kf[4],qr[2],C0,0,0,0),   P1[2],P1[3],P1[4],P1[5],     pw2[0]=PKW(P1,0), pw2[1]=PKW(P1,2), pw2); \
    VRD(6); SBAR(); GAPA(C1=__builtin_amdgcn_mfma_f32_32x32x16_bf16(kf[5],qr[2],C1,0,0,0),   P1[6],P1[7],P1[8],P1[9],     pw2[2]=PKW(P1,4), pw2[3]=PKW(P1,6), pw2); \
    VRD(3); SBAR(); GAPA(C0=__builtin_amdgcn_mfma_f32_32x32x16_bf16(kf[6],qr[3],C0,0,0,0),   P1[10],P1[11],P1[12],P1[13], pw3[0]=PKW(P1,8), pw3[1]=PKW(P1,10), pw3); \
    VRD(7); SBAR(); GAPA(C1=__builtin_amdgcn_mfma_f32_32x32x16_bf16(kf[7],qr[3],C1,0,0,0),   P1[14],P1[15],0.f,0.f,       pw3[2]=PKW(P1,12),pw3[3]=PKW(P1,14), pw3); \
    l_reg+=sacc; \
    if(GK){DMA_K((t)+3,sl_cur);} if(GV){DMA_V((t)+1,sl_next);} \
    CMASK(C0,C1,t); \
    { float a=MX3(C0[0],C0[1],C1[0]),b=MX3(C0[2],C0[3],C1[1]); a=MX3(a,C1[2],C1[3]); \
      _Pragma("unroll") for(int r=4;r<16;r+=4){a=MX3(a,C0[r],C0[r+1]);b=MX3(b,C0[r+2],C0[r+3]);a=MX3(a,C1[r],C1[r+1]);b=MX3(b,C1[r+2],C1[r+3]);} \
      float rm=__builtin_fmaxf(a,b); { auto rr=__builtin_amdgcn_permlane32_swap(__float_as_uint(rm),__float_as_uint(rm),false,false); rm=__builtin_fmaxf(__uint_as_float(rr[0]),__uint_as_float(rr[1])); } \
      resc=false; \
      if(__builtin_expect(__any(rm>(float)THRL),0)){ const float dl=__builtin_fmaxf(rm,0.f); mhat+=dl; \
        _Pragma("unroll") for(int r=0;r<16;++r){C0[r]-=dl;C1[r]-=dl;} \
        _Pragma("unroll") for(int r=0;r<16;++r)negm[r]=-mhat; asm volatile("":"+v"(negm)); \
        const float f=__builtin_amdgcn_exp2f(-dl); l_reg*=f; if(hi==0)wsf[r32]=f; resc=true; } } \
    SBAR(); \
    GAPB(o[0]=__builtin_amdgcn_mfma_f32_32x32x16_bf16(PAF(0),VFR(0),o[0],0,0,0), C0,0); \
    GAPB(o[1]=__builtin_amdgcn_mfma_f32_32x32x16_bf16(PAF(0),VFR(4),o[1],0,0,0), C0,4); \
    KRD(GL,0); GAPB(o[0]=__builtin_amdgcn_mfma_f32_32x32x16_bf16(PAF(1),VFR(1),o[0],0,0,0), C0,8); \
    KRD(GL,1); GAPB(o[1]=__builtin_amdgcn_mfma_f32_32x32x16_bf16(PAF(1),VFR(5),o[1],0,0,0), C0,12); \
    KRD(GL,2); GAPB(o[0]=__builtin_amdgcn_mfma_f32_32x32x16_bf16(PAF(2),VFR(2),o[0],0,0,0), C1,0); \
    KRD(GL,3); GAPB(o[1]=__builtin_amdgcn_mfma_f32_32x32x16_bf16(PAF(2),VFR(6),o[1],0,0,0), C1,4); \
    GAPB(o[0]=__builtin_amdgcn_mfma_f32_32x32x16_bf16(PAF(3),VFR(3),o[0],0,0,0), C1,8); \
    GAPB(o[1]=__builtin_amdgcn_mfma_f32_32x32x16_bf16(PAF(3),VFR(7),o[1],0,0,0), C1,12); \
    }while(0)
  int t=1;
  #undef CMASK
  #define CMASK(P0,P1,t) do{}while(0)
  for(;t+5<NT;t+=2){
    STEP(pB0,pB1,pA0,pA1,t,true,true,true);     WAIT_BAR(2); RESC(); ROT();
    STEP(pA0,pA1,pB0,pB1,t+1,true,true,true);   WAIT_BAR(2); RESC(); ROT();
  }
  #undef CMASK
  #define CMASK(P0,P1,t) do{int jb_=(t)-(NT-4); if(jb_>=0)cmask(P0,P1,jb_,qrel,hi);}while(0)
  #define ENDW(tt) do{ if((tt)+3<NT){WAIT_BAR(2);} else if((tt)+2<NT){WAIT_BAR(1);} else {WAIT_BAR(0);} }while(0)
  for(;t+1<NT;t+=2){
    STEP(pB0,pB1,pA0,pA1,t,(t+3<NT),(t+1<NT),(t+1<NT));       ENDW(t);   RESC(); ROT();
    STEP(pA0,pA1,pB0,pB1,t+1,(t+4<NT),(t+2<NT),(t+2<NT));     ENDW(t+1); RESC(); ROT();
  }
  STEP(pB0,pB1,pA0,pA1,NT-1,false,false,false); RESC();
  { float sacc=pB0[0]+pB0[1]; _Pragma("unroll") for(int r=2;r<16;++r)sacc+=pB0[r]; _Pragma("unroll") for(int r=0;r<16;++r)sacc+=pB1[r]; l_reg+=sacc;
    pw0=(u32x4){PKW(pB0,0),PKW(pB0,2),PKW(pB0,4),PKW(pB0,6)};pw1=(u32x4){PKW(pB0,8),PKW(pB0,10),PKW(pB0,12),PKW(pB0,14)};pw2=(u32x4){PKW(pB1,0),PKW(pB1,2),PKW(pB1,4),PKW(pB1,6)};pw3=(u32x4){PKW(pB1,8),PKW(pB1,10),PKW(pB1,12),PKW(pB1,14)};
    SBAR(); pv(o,vb0+sl_cur,PAF(0),PAF(1),PAF(2),PAF(3)); }
  #undef PKW
  #undef PAF
  #undef VFR
  #undef PIN
  #undef MX3
  #undef GAPA
  #undef GAPB
  #undef EX
  #undef VRD
  #undef KRD
  #undef STEP
  #undef ENDW
  {auto rr=__builtin_amdgcn_permlane32_swap(__float_as_uint(l_reg),__float_as_uint(l_reg),false,false);l_reg=__uint_as_float(rr[0])+__uint_as_float(rr[1]);}
  if(hi==0)wsf[32+r32]=l_reg;asm volatile("s_waitcnt lgkmcnt(0)":::"memory");
  float rli[16];
  #pragma unroll
  for(int r=0;r<16;++r)rli[r]=__builtin_amdgcn_rcpf(wsf[32+crow(r,hi)]);
  bf16*Ow=O+(rowbase+q0+wid*QBLK)*PO;
  { bf16*stg=(bf16*)(shm+LDS_OST)+wid*2048;
    #pragma unroll
    for(int r=0;r<16;++r){const int orow=crow(r,hi);
      #pragma unroll
      for(int d0=0;d0<2;++d0)stg[orow*64+d0*32+r32]=__float2bfloat16(o[d0][r]*rli[r]);}
    asm volatile("s_waitcnt lgkmcnt(0)":::"memory");
    #pragma unroll
    for(int i=0;i<4;++i){const int row=i*8+(lane>>3),ch=lane&7; const u32x4 v=*(const u32x4*)(stg+row*64+ch*8); ATTN_STORE16(Ow+(long)row*PO+ch*8,v);} }
  asm volatile("s_waitcnt lgkmcnt(0)\n\ts_barrier":::"memory");
  #undef DMA_K
  #undef DMA_V
  #undef CMASK
  #undef START
  #undef RESC
  #undef ROT
}
constexpr int ATTN_LDS_BYTES=LDS_BYTES;
struct AttnTensors { const bf16* Q; const bf16* K; const bf16* V; bf16* O; };
struct AttnUnit { int bh; int qb; };
struct StaticOrder {
  int vcu;
  __device__ __forceinline__ explicit StaticOrder(int grid,int block):vcu((block%8)*(grid/8)+block/8){}
  __device__ __forceinline__ bool next(int i,AttnUnit&u)const{ if(i>=4)return false; const int s=vcu&7; u.bh=vcu>>3; u.qb=(i==0)?s:(i==1)?15-s:(i==2)?16+s:31-s; return true; }
  __device__ __forceinline__ void a_ready(const AttnUnit&)const{}
  __device__ __forceinline__ void done(const AttnUnit&)const{}
};
template<class Sched,int THRL=8> __device__ __forceinline__ void attn_phase(char*lds,const AttnTensors&T,const Sched&S){
  AttnUnit u;
  for(int i=0;S.next(i,u);++i){ S.a_ready(u); {const int vh=u.bh%NHEAD,hh=vh>>2,mm=(vh>>1)&1,vv=vh&1; attn_unit<THRL>(u.bh/NHEAD,u.qb,T.Q+hh*128+mm*64,T.K+hh*128+mm*64,T.V+hh*128+vv*64,T.O+hh*256+mm*128+vv*64,lds);} S.done(u); }
}
#undef SBAR
#undef WAIT_BAR
}
constexpr int NWAVES = 8, NTHR = 512;
#ifndef DEPTH_
#define DEPTH_ 4
#endif
constexpr int BATCH = 2, SEQ = 8192, DM_ = 1024, DEPTH = DEPTH_, MROWS = BATCH * SEQ;
constexpr int NPROJ = 3328;
constexpr int C_Z = 0, C_X = 512, C_B = 1024, C_C = 1280, C_Q = 1536, C_K = 2048, C_V = 2560, C_DT = 3072;
constexpr int DINP = 3080, DFF = 2816, NGU = 5632, NMOD = 6144;
constexpr float LN_EPS = 1e-5f, ALPHA = 1.681792830507429f;
constexpr size_t MiB = 1u << 20;
constexpr size_t WS_CTL = 0, CTL_ZERO_BYTES = 65536;
constexpr size_t WS_MOD = 1 * MiB, WS_DEC = 1 * MiB + 256 * 1024, WS_ROPE = 2 * MiB;
constexpr size_t WS_WIN = 4 * MiB, WS_WOUT = 30 * MiB, WS_WGU = 38 * MiB, WS_WDN = 82 * MiB;
constexpr size_t WS_PROJ = 104 * MiB;
constexpr size_t WS_H = 208 * MiB;
constexpr size_t WS_OATT = 240 * MiB, WS_YCAT = 272 * MiB;
constexpr size_t WS_YSSD = 304 * MiB, WS_END = 320 * MiB;
constexpr size_t WIN_L = (size_t)NPROJ * 1024, WOUT_L = (size_t)1024 * 1024, WGU_L = (size_t)NGU * 1024, WDN_L = (size_t)1024 * DFF;
constexpr int RING_BYTES = 131072;
constexpr int LDS_BYTES = 155648;
constexpr int MISC_OFF = LDS_BYTES - 64;
#define GAS __attribute__((address_space(1)))
#define LAS __attribute__((address_space(3)))
typedef unsigned short bf16;
typedef unsigned v4u __attribute__((ext_vector_type(4)));
typedef unsigned v2u __attribute__((ext_vector_type(2)));
typedef float f32x4 __attribute__((ext_vector_type(4)));
typedef short bf16x8 __attribute__((ext_vector_type(8)));
#define LDS_WAIT() asm volatile("s_waitcnt lgkmcnt(0)" ::: "memory")
__device__ __forceinline__ unsigned f2bf(float f) { unsigned u = __builtin_bit_cast(unsigned, f); return (u + 0x7fffu + ((u >> 16) & 1u)) >> 16; }
__device__ __forceinline__ unsigned pk2(float lo, float hi) { return f2bf(lo) | (f2bf(hi) << 16); }
__device__ __forceinline__ float bflo(unsigned w) { return __builtin_bit_cast(float, w << 16); }
__device__ __forceinline__ float bfhi(unsigned w) { return __builtin_bit_cast(float, w & 0xffff0000u); }
__device__ __forceinline__ float bf1(bf16 h) { return __builtin_bit_cast(float, (unsigned)h << 16); }
__device__ __forceinline__ float wave_sum(float v) {
#pragma unroll
    for (int o = 1; o < 64; o <<= 1) v += __shfl_xor(v, o);
    return v;
}
__device__ __forceinline__ float silu_f(float x) { return x / (1.f + __expf(-x)); }
__device__ __forceinline__ float softplus_f(float x) { return x > 20.f ? x : log1pf(__expf(x)); }

#define RLX_AGENT __ATOMIC_RELAXED, __HIP_MEMORY_SCOPE_AGENT
#define XB_TMO      128
#define XB_XCNT(j)  (256  + 64 * (j))
#define XB_XSUB(j)  (1280 + 64 * (j))
#define XB_XGEN(j)  (2304 + 64 * (j))
#define XB_TOP      3328
#define XB_TOPGEN   3392
#define XCD_BAR_WORDS 3456
#define XB_SPIN_CAP (1u << 18)

__device__ __forceinline__ unsigned xb_ld(unsigned* p)              { return __hip_atomic_load(p, __ATOMIC_RELAXED, __HIP_MEMORY_SCOPE_AGENT); }
__device__ __forceinline__ unsigned xb_add(unsigned* p, unsigned v) { return __hip_atomic_fetch_add(p, v, __ATOMIC_RELAXED, __HIP_MEMORY_SCOPE_AGENT); }
__device__ __forceinline__ unsigned xb_xcc_id() { return (unsigned)__builtin_amdgcn_s_getreg((3 << 11) | 20) & 0xFu; }
#define XB_SPIN(cond, bar) do { unsigned _sp = 0; while (cond) { __builtin_amdgcn_s_sleep(1); \
    if ((++_sp & 255u) == 0u) { if (xb_ld(&(bar)[XB_TMO])) break; if (_sp > XB_SPIN_CAP) { atomicAdd(&(bar)[XB_TMO], 1u); break; } } } } while (0)

struct XcdBarrier {
    unsigned* bar; unsigned x;
    volatile LAS unsigned* st;
};

__device__ __forceinline__ XcdBarrier xcd_barrier_post(unsigned* bar, volatile LAS unsigned* st) {
    XcdBarrier b; b.bar = bar; b.x = xb_xcc_id(); b.st = st;
    if (threadIdx.x == 0) (void)xb_add(&bar[XB_XCNT(b.x)], 1u);
    return b;
}
__device__ __forceinline__ void xcd_barrier_complete(unsigned* bar, unsigned x, unsigned& nloc, unsigned& nx) {
    const unsigned G = gridDim.x * gridDim.y * gridDim.z;
    unsigned sum, cnt, mine, sp = 0u;
    for (;;) {
        sum = 0u; cnt = 0u; mine = 0u;
#pragma unroll
        for (unsigned j = 0; j < 16; ++j) { const unsigned c = xb_ld(&bar[XB_XCNT(j)]); sum += c; cnt += (c > 0u) ? 1u : 0u; mine = (j == x) ? c : mine; }
        if (sum == G) break;
        __builtin_amdgcn_s_sleep(1);
        if ((++sp & 255u) == 0u) { if (xb_ld(&bar[XB_TMO])) break; if (sp > XB_SPIN_CAP) { atomicAdd(&bar[XB_TMO], 1u); break; } }
    }
    nloc = mine > 0u ? mine : 1u; nx = cnt > 0u ? cnt : 1u;
}

__device__ __forceinline__ void xcd_barrier(const XcdBarrier& b) {
    asm volatile("s_waitcnt vmcnt(0)" ::: "memory");
    __syncthreads();
    if (threadIdx.x == 0) {
        unsigned* bar = b.bar;
        __builtin_amdgcn_s_waitcnt(0);
        unsigned nloc = b.st[0], nx = b.st[1];
        if (nloc == 0u) { xcd_barrier_complete(bar, b.x, nloc, nx); b.st[0] = nloc; b.st[1] = nx; }
        const unsigned old = xb_add(&bar[XB_XSUB(b.x)], 1u);
        const unsigned gen = old / nloc;
        if (old + 1u == (gen + 1u) * nloc) {
            __builtin_amdgcn_fence(__ATOMIC_RELEASE, "agent");
            asm volatile("s_waitcnt vmcnt(0)" ::: "memory");
            const unsigned og = xb_add(&bar[XB_TOP], 1u);
            const unsigned tg = og / nx;
            if (og + 1u == (tg + 1u) * nx) xb_add(&bar[XB_TOPGEN], 1u);
            else XB_SPIN(xb_ld(&bar[XB_TOPGEN]) == tg, bar);
            __builtin_amdgcn_fence(__ATOMIC_ACQUIRE, "agent");
            xb_add(&bar[XB_XGEN(b.x)], 1u);
            asm volatile("s_waitcnt vmcnt(0)" ::: "memory");
        } else {
            XB_SPIN(xb_ld(&bar[XB_XGEN(b.x)]) == gen, bar);
            __builtin_amdgcn_fence(__ATOMIC_ACQUIRE, "agent");
            asm volatile("s_waitcnt vmcnt(0)" ::: "memory");
        }
    }
    __syncthreads();
}

struct Args { const float* in[20]; float* out; unsigned char* ws; };

template <int MAP> __device__ __forceinline__ int colmap(int n) {
    if (MAP == 0) return n;
    if (MAP == 1) {
        if (n < C_Q) return n;
        if (n < C_V) { const int i = n - C_Q, blk = i >> 6, pos = i & 63; return 1544 + blk * 64 + (pos >> 1) + 32 * (pos & 1); }
        if (n < C_DT) return 2568 + (n - C_V);
        if (n < C_DT + 8) return 1536 + (n - C_DT);
        return -1;
    }
    return (n >> 1) + DFF * (n & 1);
}
template <int MAP> __device__ __forceinline__ void transpose_item(const float* W, int K, int Nsrc, int Ndst, bf16* WT, LAS float* scr, int item, int lane) {
    const int nblk = Ndst / 32, kb = item / nblk, nb = item % nblk, k0 = 64 * kb, n0 = 32 * nb;
    const int sc = colmap<MAP>(n0 + (lane & 31));
#pragma unroll 8
    for (int i = 0; i < 32; ++i) { const int kk = 2 * i + (lane >> 5); scr[kk * 33 + (lane & 31)] = sc >= 0 ? W[(size_t)(k0 + kk) * Nsrc + sc] : 0.f; }
    LDS_WAIT(); asm volatile("" ::: "memory");
    const int c = lane & 7;
#pragma unroll
    for (int j = 0; j < 4; ++j) { const int n = (lane >> 3) + 8 * j; const LAS float* s = scr + (8 * c) * 33 + n;
        v4u o; o.x = pk2(s[0 * 33], s[1 * 33]); o.y = pk2(s[2 * 33], s[3 * 33]); o.z = pk2(s[4 * 33], s[5 * 33]); o.w = pk2(s[6 * 33], s[7 * 33]);
        *(v4u*)(WT + (size_t)(n0 + n) * K + k0 + 8 * c) = o; }
    LDS_WAIT(); asm volatile("" ::: "memory");
}
__device__ __forceinline__ void p0_weights(const Args& a, LAS unsigned char* lds, int gw, int NGW, int wave, int lane) {
    LAS float* scr = (LAS float*)(lds + wave * 16384);
    constexpr int I_IN = (1024 / 64) * (NPROJ / 32), I_OUT = (1024 / 64) * (1024 / 32), I_GU = (1024 / 64) * (NGU / 32), I_DN = (DFF / 64) * (1024 / 32);
    constexpr int PER_L = I_IN + I_OUT + I_GU + I_DN;
    unsigned char* ws = a.ws;
    for (int it = gw; it < DEPTH * PER_L; it += NGW) {
        const int l = it / PER_L; int r = it % PER_L;
        if (r < I_IN) { transpose_item<1>(a.in[4] + (size_t)l * 1024 * DINP, 1024, DINP, NPROJ, (bf16*)(ws + WS_WIN) + l * WIN_L, scr, r, lane); continue; } r -= I_IN;
        if (r < I_OUT) { transpose_item<0>(a.in[13] + (size_t)l * 1024 * 1024, 1024, 1024, 1024, (bf16*)(ws + WS_WOUT) + l * WOUT_L, scr, r, lane); continue; } r -= I_OUT;
        if (r < I_GU) { transpose_item<2>(a.in[16] + (size_t)l * 1024 * NGU, 1024, NGU, NGU, (bf16*)(ws + WS_WGU) + l * WGU_L, scr, r, lane); continue; } r -= I_GU;
        transpose_item<0>(a.in[17] + (size_t)l * DFF * 1024, DFF, 1024, 1024, (bf16*)(ws + WS_WDN) + l * WDN_L, scr, r, lane);
    }
}
__device__ __forceinline__ void p0_mod(const Args& a, LAS unsigned char* lds, int vcu, int G, int tid) {
    LAS float* sc = (LAS float*)lds;
    LAS float* red = sc + 2048;
    const float* c = a.in[1];
    for (int i = tid; i < 2048; i += NTHR) sc[i] = silu_f(c[i]);
    __syncthreads();
    float* mod = (float*)(a.ws + WS_MOD);
    const int col = tid & 63, ks = tid >> 6;
    for (int it = vcu; it < DEPTH * (NMOD / 64); it += G) {
        const int l = it / (NMOD / 64), n0 = (it % (NMOD / 64)) * 64;
        const float* W = a.in[2] + (size_t)l * 1024 * NMOD + n0 + col;
        float a0 = 0.f, a1 = 0.f;
#pragma unroll 8
        for (int k = ks * 128; k < ks * 128 + 128; ++k) { const float w = W[(size_t)k * NMOD]; a0 += sc[k] * w; a1 += sc[1024 + k] * w; }
        red[(ks * 64 + col) * 2] = a0; red[(ks * 64 + col) * 2 + 1] = a1;
        __syncthreads();
        if (tid < 128) { const int cc = tid & 63, b = tid >> 6; float s = 0.f;
#pragma unroll
            for (int q = 0; q < 8; ++q) s += red[(q * 64 + cc) * 2 + b];
            mod[((size_t)l * 2 + b) * NMOD + n0 + cc] = s + a.in[3][(size_t)l * NMOD + n0 + cc]; }
        __syncthreads();
    }
}
__device__ __forceinline__ void p0_rope(const Args& a, int gtid, int NT) {
    float* rope = (float*)(a.ws + WS_ROPE);
    for (int i = gtid; i < SEQ * 32; i += NT) {
        const int t = i >> 5, j = i & 31;
        double inv = 1.0; for (int q = 0; q < j; ++q) inv *= 0.7498942093324559;
        const float invf = (float)inv; const float ang = (float)t * invf;
        double r = (double)ang; const double kq = __builtin_rint(r * 0.15915494309189535); r = r - kq * 6.283185307179586;
        const double r2 = r * r;
        double s = 1.0, cc = 1.0;
#pragma unroll
        for (int n = 12; n >= 1; --n) { s = 1.0 - s * r2 / (double)((2 * n) * (2 * n + 1)); cc = 1.0 - cc * r2 / (double)((2 * n - 1) * (2 * n)); }
        rope[2 * i] = (float)cc; rope[2 * i + 1] = (float)(s * r);
    }
}
__device__ __forceinline__ void p0_h0(const Args& a, int gw, int NGW, int lane) {
    const float* mod = (const float*)(a.ws + WS_MOD);
    bf16* H = (bf16*)(a.ws + WS_H);
    for (int m = gw; m < MROWS; m += NGW) {
        const int b = m >> 13; const float* mb = mod + (size_t)b * NMOD;
        const f32x4* xr = (const f32x4*)(a.in[0] + (size_t)m * 1024) + lane;
        unsigned long long* o8 = (unsigned long long*)(H + (size_t)m * 1024) + lane;
#pragma unroll
        for (int j = 0; j < 4; ++j) { const f32x4 v = xr[64 * j]; const f32x4 sh = *((const f32x4*)mb + lane + 64 * j), scl = *((const f32x4*)(mb + 1024) + lane + 64 * j);
            const f32x4 h = v * (scl + 1.f) + sh;
            o8[64 * j] = (unsigned long long)pk2(h.x, h.y) | ((unsigned long long)pk2(h.z, h.w) << 32); }
    }
}
__device__ __forceinline__ void ln_pass(const float* xin, const float* y, float* xout, bf16* H, const float* gate  , const float* lg, const float* lb,
                                        const float* hshift, const float* hscale, int gw, int NGW, int lane) {
    for (int m = gw; m < MROWS; m += NGW) {
        const int b = m >> 13;
        const f32x4* xr = (const f32x4*)(xin + (size_t)m * 1024) + lane; const f32x4* yr = (const f32x4*)(y + (size_t)m * 1024) + lane;
        const f32x4* gr = (const f32x4*)(gate + (size_t)b * NMOD) + lane;
        f32x4 v[4]; float s = 0.f;
#pragma unroll
        for (int j = 0; j < 4; ++j) { v[j] = xr[64 * j] * ALPHA + (gr[64 * j] + 1.f) * yr[64 * j]; s += (v[j].x + v[j].y) + (v[j].z + v[j].w); }
        const float mean = wave_sum(s) * (1.f / 1024.f); float s2 = 0.f;
#pragma unroll
        for (int j = 0; j < 4; ++j) { v[j] = v[j] - mean; s2 += (v[j].x * v[j].x + v[j].y * v[j].y) + (v[j].z * v[j].z + v[j].w * v[j].w); }
        const float rstd = 1.f / sqrtf(wave_sum(s2) * (1.f / 1024.f) + LN_EPS);
        f32x4* xo = (f32x4*)(xout + (size_t)m * 1024) + lane;
        unsigned long long* o8 = (unsigned long long*)(H + (size_t)m * 1024) + lane;
#pragma unroll
        for (int j = 0; j < 4; ++j) { const f32x4 xn = v[j] * rstd * *((const f32x4*)lg + lane + 64 * j) + *((const f32x4*)lb + lane + 64 * j);
            xo[64 * j] = xn;
            if (hshift) { const f32x4 h = xn * (*((const f32x4*)(hscale + (size_t)b * NMOD) + lane + 64 * j) + 1.f) + *((const f32x4*)(hshift + (size_t)b * NMOD) + lane + 64 * j);
                o8[64 * j] = (unsigned long long)pk2(h.x, h.y) | ((unsigned long long)pk2(h.z, h.w) << 32); } }
    }
}
__device__ __forceinline__ void finalize_pass(const Args& a, int l, int gw, int NGW, int lane) {
    const bf16* YS = (const bf16*)(a.ws + WS_YSSD); const bf16* OA = (const bf16*)(a.ws + WS_OATT); bf16* YC = (bf16*)(a.ws + WS_YCAT);
    const float* lq = a.in[11] + (size_t)l * 256;
    const float e1 = wave_sum(lq[lane] * lq[64 + lane]), e2 = wave_sum(lq[128 + lane] * lq[192 + lane]);
    const float lam_init = 0.8f - 0.6f * expf(-0.3f * (float)l);
    const float lam = expf(e1) - expf(e2) + lam_init;
    float wn[8], wa[8];
#pragma unroll
    for (int j = 0; j < 8; ++j) { wn[j] = a.in[10][(size_t)l * 512 + lane * 8 + j]; wa[j] = a.in[12][(size_t)l * 128 + (lane & 15) * 8 + j] * (1.f - lam_init); }
    for (int m = gw; m < MROWS; m += NGW) {
        const v4u ys = *((const v4u*)(YS + (size_t)m * 512) + lane);
        const int hh = lane >> 4, d0 = (lane & 15) * 8;
        const v4u o1 = *(const v4u*)(OA + (size_t)m * 1024 + hh * 256 + d0), o2 = *(const v4u*)(OA + (size_t)m * 1024 + hh * 256 + 128 + d0);
        float y[8] = {bflo(ys.x), bfhi(ys.x), bflo(ys.y), bfhi(ys.y), bflo(ys.z), bfhi(ys.z), bflo(ys.w), bfhi(ys.w)};
        float p[8] = {bflo(o1.x), bfhi(o1.x), bflo(o1.y), bfhi(o1.y), bflo(o1.z), bfhi(o1.z), bflo(o1.w), bfhi(o1.w)};
        float q[8] = {bflo(o2.x), bfhi(o2.x), bflo(o2.y), bfhi(o2.y), bflo(o2.z), bfhi(o2.z), bflo(o2.w), bfhi(o2.w)};
        float sy = 0.f, so = 0.f;
#pragma unroll
        for (int j = 0; j < 8; ++j) { sy += y[j] * y[j]; p[j] = p[j] - lam * q[j]; so += p[j] * p[j]; }
#pragma unroll
        for (int o = 1; o < 32; o <<= 1) sy += __shfl_xor(sy, o);
#pragma unroll
        for (int o = 1; o < 16; o <<= 1) so += __shfl_xor(so, o);
        const float ry = 1.f / sqrtf(sy * (1.f / 256.f) + LN_EPS), ro = 1.f / sqrtf(so * (1.f / 128.f) + LN_EPS);
        v4u w1, w2;
        w1.x = pk2(y[0] * ry * wn[0], y[1] * ry * wn[1]); w1.y = pk2(y[2] * ry * wn[2], y[3] * ry * wn[3]); w1.z = pk2(y[4] * ry * wn[4], y[5] * ry * wn[5]); w1.w = pk2(y[6] * ry * wn[6], y[7] * ry * wn[7]);
        w2.x = pk2(p[0] * ro * wa[0], p[1] * ro * wa[1]); w2.y = pk2(p[2] * ro * wa[2], p[3] * ro * wa[3]); w2.z = pk2(p[4] * ro * wa[4], p[5] * ro * wa[5]); w2.w = pk2(p[6] * ro * wa[6], p[7] * ro * wa[7]);
        *((v4u*)(YC + (size_t)m * 1024) + lane) = w1;
        *(v4u*)(YC + (size_t)m * 1024 + 512 + hh * 128 + d0) = w2;
    }
}
constexpr int SP = 136, SPB = SP * 2;
constexpr int L_C = 0, L_B = 128 * SPB, L_M = 2 * 128 * SPB, L_XT = 3 * 128 * SPB, L_PV = L_XT + 64 * SPB, L_TAB = L_PV + 64 * SPB;
static_assert(L_TAB + 4096 <= LDS_BYTES, "ssd lds");
template <int NT> __device__ __forceinline__ void conv_tile(float (&v)[NT][8], const bf16* P, int col, size_t row, int t, const float* cw, const float* cb) {
    const int ch = col - C_X;
    float w[4][8], bias[8];
#pragma unroll
    for (int k = 0; k < 4; ++k) { const f32x4 a = *(const f32x4*)(cw + k * 1024 + ch), b = *(const f32x4*)(cw + k * 1024 + ch + 4);
        w[k][0] = a.x; w[k][1] = a.y; w[k][2] = a.z; w[k][3] = a.w; w[k][4] = b.x; w[k][5] = b.y; w[k][6] = b.z; w[k][7] = b.w; }
    { const f32x4 a = *(const f32x4*)(cb + ch), b = *(const f32x4*)(cb + ch + 4); bias[0] = a.x; bias[1] = a.y; bias[2] = a.z; bias[3] = a.w; bias[4] = b.x; bias[5] = b.y; bias[6] = b.z; bias[7] = b.w; }
    float u[NT + 3][8];
#pragma unroll
    for (int i = 0; i < NT + 3; ++i) {
        v4u r = (v4u){0u, 0u, 0u, 0u};
        if (t + i - 3 >= 0) r = *(const v4u*)(P + (row + i - 3) * NPROJ + col);
        u[i][0] = bflo(r.x); u[i][1] = bfhi(r.x); u[i][2] = bflo(r.y); u[i][3] = bfhi(r.y); u[i][4] = bflo(r.z); u[i][5] = bfhi(r.z); u[i][6] = bflo(r.w); u[i][7] = bfhi(r.w);
    }
#pragma unroll
    for (int i = 0; i < NT; ++i)
#pragma unroll
        for (int c = 0; c < 8; ++c) { const float s = bias[c] + w[0][c] * u[i][c] + w[1][c] * u[i + 1][c] + w[2][c] * u[i + 2][c] + w[3][c] * u[i + 3][c]; v[i][c] = silu_f(s); }
}
__device__ __forceinline__ void ssd_tables(const Args& a, int l, LAS unsigned char* lds, const bf16* P, size_t row0, int g, int tid) {
    LAS float* acs = (LAS float*)(lds + L_TAB); LAS float* dtv = acs + 512;
    const int e = tid >> 7, ll = tid & 127, h = g * 4 + e;
    const float dt = softplus_f(bf1(P[(row0 + ll) * NPROJ + C_DT + h]) + a.in[7][l * 8 + h]);
    const float av = -__expf(a.in[8][l * 8 + h]) * dt;
    dtv[tid] = dt; acs[tid] = av;
    __syncthreads();
    float s = 0.f;
    for (int k = 0; k <= ll; ++k) s += acs[e * 128 + k];
    __syncthreads();
    acs[tid] = s;
    __syncthreads();
}
__device__ __forceinline__ bf16x8 ldfrag(const LAS unsigned char* base, int row, int kel) { return *(const LAS bf16x8*)(base + row * SPB + kel * 2); }
__device__ __forceinline__ void ssd_states_unit(const Args& a, int l, LAS unsigned char* lds, int unit, int tid, int wave, int lane) {
    const int g = unit & 1, c = (unit >> 1) & 63, b = unit >> 7;
    const bf16* P = (const bf16*)(a.ws + WS_PROJ); const size_t row0 = (size_t)b * SEQ + c * 128; const int t0 = c * 128;
    const float* cw = a.in[5] + (size_t)l * 4 * 1024; const float* cb = a.in[6] + (size_t)l * 1024;
    ssd_tables(a, l, lds, P, row0, g, tid);
    LAS float* acs = (LAS float*)(lds + L_TAB); LAS float* dtv = acs + 512;
    if (tid < 4) ((float*)(a.ws + WS_DEC))[(b * 64 + c) * 8 + g * 4 + tid] = __expf(acs[tid * 128 + 127]);
    {
        const int cg8 = tid & 31, ts = tid >> 5, e = cg8 >> 3;
        float v[8][8]; conv_tile<8>(v, P, C_X + g * 256 + cg8 * 8, row0 + ts * 8, t0 + ts * 8, cw, cb);
        float wl[8]; const float alast = acs[e * 128 + 127];
#pragma unroll
        for (int i = 0; i < 8; ++i) wl[i] = dtv[e * 128 + ts * 8 + i] * __expf(alast - acs[e * 128 + ts * 8 + i]);
#pragma unroll
        for (int cc = 0; cc < 8; ++cc) { v4u o; o.x = pk2(v[0][cc] * wl[0], v[1][cc] * wl[1]); o.y = pk2(v[2][cc] * wl[2], v[3][cc] * wl[3]); o.z = pk2(v[4][cc] * wl[4], v[5][cc] * wl[5]); o.w = pk2(v[6][cc] * wl[6], v[7][cc] * wl[7]);
            *(LAS v4u*)(lds + L_B + (cg8 * 8 + cc) * SPB + ts * 16) = o; }
    }
    if (tid < 256) {
        const int cg8 = tid & 15, ts = tid >> 4;
        float v[8][8]; conv_tile<8>(v, P, C_B + g * 128 + cg8 * 8, row0 + ts * 8, t0 + ts * 8, cw, cb);
#pragma unroll
        for (int cc = 0; cc < 8; ++cc) { v4u o; o.x = pk2(v[0][cc], v[1][cc]); o.y = pk2(v[2][cc], v[3][cc]); o.z = pk2(v[4][cc], v[5][cc]); o.w = pk2(v[6][cc], v[7][cc]);
            *(LAS v4u*)(lds + L_C + (cg8 * 8 + cc) * SPB + ts * 16) = o; }
    }
    __syncthreads();
    {
        const int e = wave >> 1, nh = wave & 1, fr = lane & 15, fq = lane >> 4;
        f32x4 acc[4][4];
#pragma unroll
        for (int i = 0; i < 4; ++i)
#pragma unroll
            for (int j = 0; j < 4; ++j) acc[i][j] = (f32x4){0.f, 0.f, 0.f, 0.f};
#pragma unroll
        for (int ks = 0; ks < 4; ++ks) {
            bf16x8 af[4], bfr[4];
#pragma unroll
            for (int i = 0; i < 4; ++i) { af[i] = ldfrag(lds + L_B, e * 64 + i * 16 + fr, ks * 32 + fq * 8); bfr[i] = ldfrag(lds + L_C, nh * 64 + i * 16 + fr, ks * 32 + fq * 8); }
#pragma unroll
            for (int i = 0; i < 4; ++i)
#pragma unroll
                for (int j = 0; j < 4; ++j) acc[i][j] = __builtin_amdgcn_mfma_f32_16x16x32_bf16(af[i], bfr[j], acc[i][j], 0, 0, 0);
        }
        float* ST = (float*)(a.ws + WS_H) + ((size_t)((b * 64 + c) * 8 + g * 4 + e)) * 8192;
#pragma unroll
        for (int i = 0; i < 4; ++i)
#pragma unroll
            for (int j = 0; j < 4; ++j)
#pragma unroll
                for (int r = 0; r < 4; ++r) ST[(i * 16 + fq * 4 + r) * 128 + nh * 64 + j * 16 + fr] = acc[i][j][r];
    }
    __syncthreads();
}
__device__ __forceinline__ void ssd_scan(const Args& a, int gtid, int NT) {
    float* ST = (float*)(a.ws + WS_H); const float* DEC = (const float*)(a.ws + WS_DEC);
    for (int i = gtid; i < 2 * 8 * 8192; i += NT) {
        const int b = i >> 16, rem = i & 65535, h = rem >> 13;
        float* p = ST + (size_t)b * 64 * 65536 + rem; const float* d = DEC + b * 512 + h;
        float hs = 0.f;
#pragma unroll 8
        for (int c = 0; c < 64; ++c) { const float st = p[(size_t)c * 65536]; p[(size_t)c * 65536] = hs; hs = d[c * 8] * hs + st; }
    }
}
__device__ __forceinline__ void ssd_out_unit(const Args& a, int l, LAS unsigned char* lds, int unit, int tid, int wave, int lane) {
    const int g = unit & 1, c = (unit >> 1) & 63, b = unit >> 7;
    const bf16* P = (const bf16*)(a.ws + WS_PROJ); const size_t row0 = (size_t)b * SEQ + c * 128; const int t0 = c * 128;
    const float* cw = a.in[5] + (size_t)l * 4 * 1024; const float* cb = a.in[6] + (size_t)l * 1024;
    bf16* YS = (bf16*)(a.ws + WS_YSSD);
    ssd_tables(a, l, lds, P, row0, g, tid);
    LAS float* acs = (LAS float*)(lds + L_TAB); LAS float* dtv = acs + 512;
    {
        const int cg8 = tid & 31, ts = tid >> 5, isC = cg8 >> 4, cgi = cg8 & 15;
        float v[8][8]; conv_tile<8>(v, P, (isC ? C_C : C_B) + g * 128 + cgi * 8, row0 + ts * 8, t0 + ts * 8, cw, cb);
#pragma unroll
        for (int i = 0; i < 8; ++i) { v4u o; o.x = pk2(v[i][0], v[i][1]); o.y = pk2(v[i][2], v[i][3]); o.z = pk2(v[i][4], v[i][5]); o.w = pk2(v[i][6], v[i][7]);
            *(LAS v4u*)(lds + (isC ? L_C : L_B) + (ts * 8 + i) * SPB + cgi * 16) = o; }
    }
    __syncthreads();
    const int fr = lane & 15, fq = lane >> 4;
    f32x4 cbm[8];
#pragma unroll
    for (int j = 0; j < 8; ++j) cbm[j] = (f32x4){0.f, 0.f, 0.f, 0.f};
#pragma unroll
    for (int ks = 0; ks < 4; ++ks) {
        const bf16x8 af = ldfrag(lds + L_C, wave * 16 + fr, ks * 32 + fq * 8);
#pragma unroll
        for (int j = 0; j < 8; ++j) { const bf16x8 bfr = ldfrag(lds + L_B, j * 16 + fr, ks * 32 + fq * 8); cbm[j] = __builtin_amdgcn_mfma_f32_16x16x32_bf16(af, bfr, cbm[j], 0, 0, 0); }
    }
    for (int e = 0; e < 4; ++e) {
        const int h = g * 4 + e;
        __syncthreads();
        {
            const int cg8 = tid & 7, ts = tid >> 3;
            float v[2][8]; conv_tile<2>(v, P, C_X + g * 256 + e * 64 + cg8 * 8, row0 + ts * 2, t0 + ts * 2, cw, cb);
#pragma unroll
            for (int cc = 0; cc < 8; ++cc) *(LAS unsigned*)(lds + L_XT + (cg8 * 8 + cc) * SPB + ts * 4) = pk2(v[0][cc], v[1][cc]);
        }
        {
            const float* ST = (const float*)(a.ws + WS_H) + ((size_t)((b * 64 + c) * 8 + h)) * 8192;
            const int p = tid >> 3, n0 = (tid & 7) * 16;
            const f32x4 s0 = *(const f32x4*)(ST + p * 128 + n0), s1 = *(const f32x4*)(ST + p * 128 + n0 + 4), s2 = *(const f32x4*)(ST + p * 128 + n0 + 8), s3 = *(const f32x4*)(ST + p * 128 + n0 + 12);
            v4u o0, o1; o0.x = pk2(s0.x, s0.y); o0.y = pk2(s0.z, s0.w); o0.z = pk2(s1.x, s1.y); o0.w = pk2(s1.z, s1.w); o1.x = pk2(s2.x, s2.y); o1.y = pk2(s2.z, s2.w); o1.z = pk2(s3.x, s3.y); o1.w = pk2(s3.z, s3.w);
            *(LAS v4u*)(lds + L_PV + p * SPB + n0 * 2) = o0; *(LAS v4u*)(lds + L_PV + p * SPB + n0 * 2 + 16) = o1;
        }
        {
            const float dsk = a.in[9][l * 8 + h];
#pragma unroll
            for (int r = 0; r < 4; ++r) { const int ll = wave * 16 + fq * 4 + r; const float al = acs[e * 128 + ll];
#pragma unroll
                for (int j = 0; j < 8; ++j) { const int s = j * 16 + fr;
                    float mv = 0.f;
                    if (s <= ll) { mv = cbm[j][r] * __expf(al - acs[e * 128 + s]) * dtv[e * 128 + s]; if (s == ll) mv += dsk; }
                    *(LAS bf16*)(lds + L_M + ll * SPB + s * 2) = (bf16)f2bf(mv); } }
        }
        __syncthreads();
        f32x4 y1[4], y2[4];
#pragma unroll
        for (int j = 0; j < 4; ++j) { y1[j] = (f32x4){0.f, 0.f, 0.f, 0.f}; y2[j] = y1[j]; }
#pragma unroll
        for (int ks = 0; ks < 4; ++ks) {
            const bf16x8 am = ldfrag(lds + L_M, wave * 16 + fr, ks * 32 + fq * 8), ac = ldfrag(lds + L_C, wave * 16 + fr, ks * 32 + fq * 8);
#pragma unroll
            for (int j = 0; j < 4; ++j) { const bf16x8 bx = ldfrag(lds + L_XT, j * 16 + fr, ks * 32 + fq * 8), bp = ldfrag(lds + L_PV, j * 16 + fr, ks * 32 + fq * 8);
                y1[j] = __builtin_amdgcn_mfma_f32_16x16x32_bf16(am, bx, y1[j], 0, 0, 0); y2[j] = __builtin_amdgcn_mfma_f32_16x16x32_bf16(ac, bp, y2[j], 0, 0, 0); }
        }
#pragma unroll
        for (int r = 0; r < 4; ++r) { const int ll = wave * 16 + fq * 4 + r; const float ea = __expf(acs[e * 128 + ll]);
#pragma unroll
            for (int j = 0; j < 4; ++j) { const int ch = g * 256 + e * 64 + j * 16 + fr;
                const float z = bf1(P[(row0 + ll) * NPROJ + C_Z + ch]);
                const float y = (y1[j][r] + ea * y2[j][r]) * silu_f(z);
                YS[(row0 + ll) * 512 + ch] = (bf16)f2bf(y); } }
    }
    __syncthreads();
}
struct AttnSched {
    int G, bx, vcu;
    __device__ __forceinline__ bool next(int i, attn_body::AttnUnit& u) const {
        if (G == 256) { if (i >= 4) return false; const int s = vcu & 7; u.bh = vcu >> 3; u.qb = (i == 0) ? s : (i == 1) ? 15 - s : (i == 2) ? 16 + s : 31 - s; return true; }
        const int idx = bx + i * G; if (idx >= 1024) return false; u.bh = idx & 31; u.qb = 31 - (idx >> 5); return true;
    }
    __device__ __forceinline__ void a_ready(const attn_body::AttnUnit&) const {}
    __device__ __forceinline__ void done(const attn_body::AttnUnit&) const {}
};

#define PH_BEGIN { int tid = opaque_tid(); const int lane = tid & 63, wave = __builtin_amdgcn_readfirstlane(tid >> 6); \
    int bx = blockIdx.x, G = gridDim.x; unsigned long long wsi_ = (unsigned long long)a.ws; asm volatile("" : "+s"(bx), "+s"(G), "+s"(wsi_)); unsigned char* ws = (unsigned char*)(__attribute__((address_space(1))) unsigned char*)wsi_; \
    const int vcu = (G % 8 == 0) ? (bx % 8) * (G / 8) + bx / 8 : bx; const int NGW = G * NWAVES, NTT = G * NTHR, gw = vcu * NWAVES + wave, gtid = bx * NTHR + tid; \
    (void)lane; (void)wave; (void)vcu; (void)NGW; (void)NTT; (void)gw; (void)gtid; (void)ws;
#define PH_END }
__global__ void __launch_bounds__(NTHR, 2) fwd_kernel(Args a) {
    extern __shared__ __attribute__((aligned(16))) unsigned char lds_raw[];
    cg::grid_group grid = cg::this_grid();
    LAS unsigned char* lds = (LAS unsigned char*)lds_raw;
    if (threadIdx.x < 16) ((LAS unsigned*)(lds + MISC_OFF))[threadIdx.x] = 0u;
    __syncthreads();
    XcdBarrier bar = xcd_barrier_post((unsigned*)(a.ws + WS_CTL) + 256, (volatile LAS unsigned*)(lds + MISC_OFF));
#define GSYNC() xcd_barrier(bar)

    PH_BEGIN
        p0_mod(a, lds, bx, G, tid);
        p0_rope(a, gtid, NTT);
        p0_weights(a, lds, gw, NGW, wave, lane);
    PH_END
    grid.sync();
    PH_BEGIN p0_h0(a, gw, NGW, lane); PH_END
    GSYNC();

#pragma unroll 1
    for (int l = 0; l < DEPTH; ++l) {
#ifndef NO_G1
        PH_BEGIN
            pg8::Gemm g{(const bf16*)(ws + WS_H), (const bf16*)(ws + WS_WIN) + l * WIN_L, MROWS, NPROJ, 1024}; pg8::StaticOrder S; S.init(MROWS, NPROJ, G, bx);
            pg8::EpiInProj E{(bf16*)(ws + WS_PROJ), NPROJ, (const float*)(ws + WS_ROPE), attn_body::C2};
            pg8::gemm_phase<pg8::EpiInProj, pg8::StaticOrder, true, true>(lds, g, S, E);
        PH_END
#endif
        GSYNC();
#ifndef NO_S1
        PH_BEGIN for (int u = bx; u < 256; u += G) ssd_states_unit(a, l, lds, u, tid, wave, lane); PH_END
#endif
        GSYNC();
        PH_BEGIN ssd_scan(a, gtid, NTT); PH_END
        GSYNC();
#ifndef NO_S3
        PH_BEGIN for (int u = bx; u < 256; u += G) ssd_out_unit(a, l, lds, u, tid, wave, lane); PH_END
#endif
#ifndef NO_ATT
        PH_BEGIN
            const attn_body::AttnTensors AT{(const attn_body::bf16*)(ws + WS_PROJ) + C_Q, (const attn_body::bf16*)(ws + WS_PROJ) + C_K, (const attn_body::bf16*)(ws + WS_PROJ) + C_V, (attn_body::bf16*)(ws + WS_OATT)};
            const AttnSched S{G, bx, vcu};
            attn_body::attn_phase<AttnSched>((char*)lds_raw, AT, S);
        PH_END
#endif
        GSYNC();
        PH_BEGIN finalize_pass(a, l, gw, NGW, lane); PH_END
        GSYNC();
#ifndef NO_G2
        PH_BEGIN
            pg8::Gemm g{(const bf16*)(ws + WS_YCAT), (const bf16*)(ws + WS_WOUT) + l * WOUT_L, MROWS, 1024, 1024}; pg8::StaticOrder S; S.init(MROWS, 1024, G, bx);
            pg8::EpiF32 E{(float*)(ws + WS_PROJ), 1024};
            pg8::gemm_phase<pg8::EpiF32, pg8::StaticOrder, true, true>(lds, g, S, E);
        PH_END
#endif
        GSYNC();
        PH_BEGIN
            const float* modl = (const float*)(ws + WS_MOD) + (size_t)l * 2 * NMOD;
            ln_pass(l == 0 ? a.in[0] : a.out, (const float*)(ws + WS_PROJ), a.out, (bf16*)(ws + WS_H), modl + 2 * 1024, a.in[14] + l * 1024, a.in[15] + l * 1024, modl + 3 * 1024, modl + 4 * 1024, gw, NGW, lane);
        PH_END
        GSYNC();
#ifndef NO_G3
        PH_BEGIN
            pg8::Gemm g{(const bf16*)(ws + WS_H), (const bf16*)(ws + WS_WGU) + l * WGU_L, MROWS, NGU, 1024}; pg8::StaticOrder S; S.init(MROWS, NGU, G, bx);
            pg8::EpiSwiGLU E{(bf16*)(ws + WS_PROJ), DFF};
            pg8::gemm_phase<pg8::EpiSwiGLU, pg8::StaticOrder, true, true>(lds, g, S, E);
        PH_END
#endif
        GSYNC();
#ifndef NO_G4
        PH_BEGIN
            pg8::Gemm g{(const bf16*)(ws + WS_PROJ), (const bf16*)(ws + WS_WDN) + l * WDN_L, MROWS, 1024, DFF}; pg8::StaticOrder S; S.init(MROWS, 1024, G, bx);
            pg8::EpiF32 E{(float*)(ws + WS_OATT), 1024};
            pg8::gemm_phase<pg8::EpiF32, pg8::StaticOrder, true, true>(lds, g, S, E);
        PH_END
#endif
        GSYNC();
        PH_BEGIN
            const float* modl = (const float*)(ws + WS_MOD) + (size_t)l * 2 * NMOD;
            const bool last = (l == DEPTH - 1); const float* modn = modl + 2 * NMOD;
            ln_pass(a.out, (const float*)(ws + WS_OATT), a.out, (bf16*)(ws + WS_H), modl + 5 * 1024, a.in[18] + l * 1024, a.in[19] + l * 1024, last ? nullptr : modn, last ? nullptr : modn + 1024, gw, NGW, lane);
        PH_END
        GSYNC();
    }
}

extern "C" void kernel_launch(void* const* d_in, const int* in_sizes, int n_in, void* d_out, int out_size, void* d_ws, size_t ws_size, hipStream_t stream) {
    static int grid = 0;
    if (grid == 0) {
        if (n_in != 20 || in_sizes[0] != MROWS * 1024 || out_size != MROWS * 1024 || ws_size < WS_END) { fprintf(stderr, "kernel_launch: unexpected shapes / workspace (n_in %d, ws %zu)\n", n_in, ws_size); grid = -1; return; }
        int dev = 0, cus = 0, per_cu = 0;
        if (hipGetDevice(&dev) != hipSuccess || hipDeviceGetAttribute(&cus, hipDeviceAttributeMultiprocessorCount, dev) != hipSuccess) { grid = -1; return; }
        if (hipFuncSetAttribute((const void*)fwd_kernel, hipFuncAttributeMaxDynamicSharedMemorySize, LDS_BYTES) != hipSuccess) { fprintf(stderr, "kernel_launch: hipFuncSetAttribute failed\n"); grid = -1; return; }
        if (hipOccupancyMaxActiveBlocksPerMultiprocessor(&per_cu, (const void*)fwd_kernel, NTHR, LDS_BYTES) != hipSuccess || per_cu < 1) { fprintf(stderr, "kernel_launch: occupancy query says %d\n", per_cu); per_cu = 1; }
        (void)hipGetLastError();
        grid = cus;
    }
    if (grid < 0) return;
    if (hipMemsetAsync((char*)d_ws + WS_CTL, 0, CTL_ZERO_BYTES, stream) != hipSuccess) { fprintf(stderr, "kernel_launch: memset failed\n"); return; }
    Args a{};
    for (int i = 0; i < 20; ++i) a.in[i] = (const float*)d_in[i];
    a.out = (float*)d_out; a.ws = (unsigned char*)d_ws;
    void* args[] = {&a};
    hipError_t e = hipLaunchCooperativeKernel((const void*)fwd_kernel, dim3(grid), dim3(NTHR), args, LDS_BYTES, stream);
    if (e != hipSuccess) fprintf(stderr, "cooperative launch failed: %s (grid %d)\n", hipGetErrorString(e), grid);
}
```
